# Optimizing an MI355X kernel written in HIP

```python
import math
import jax, jax.numpy as jnp
from jax import lax
import numpy as np

D_MODEL = 1024
BATCH = 16
SEQ = 2048
DEPTH = 1

D_MIX = 2 * D_MODEL
POOL_WINDOWS = (2, 4, 8, 16)
N_POOL_GROUPS = len(POOL_WINDOWS)
D_POOL = D_MIX // 4
POOL_GROUP = D_POOL // N_POOL_GROUPS
D_SSD = D_MIX - D_POOL
SSD_HEAD_DIM = 64
N_SSD_HEADS = D_SSD // SSD_HEAD_DIM
N_BC_GROUPS = 4
HEADS_PER_GROUP = N_SSD_HEADS // N_BC_GROUPS
D_STATE = 128
CONV_WIDTH = 4
CHUNK = 128
D_CONV = D_SSD + 2 * N_BC_GROUPS * D_STATE
D_IN_PROJ = D_POOL + D_SSD + D_CONV + N_SSD_HEADS
D_FF = 4 * D_MODEL
ALPHA = (2.0 * DEPTH) ** 0.25
BETA = (8.0 * DEPTH) ** -0.25
LN_EPS = 1e-5
RMS_EPS = 1e-5

kernel_name = "hybrid_pool_ssd_deepnorm_block"


def layer_norm(x, g, b):
    xf = x.astype(jnp.float32)
    mu = jnp.mean(xf, axis=-1, keepdims=True)
    var = jnp.mean(jnp.square(xf - mu), axis=-1, keepdims=True)
    return ((xf - mu) * lax.rsqrt(var + LN_EPS) * g + b).astype(x.dtype)


def pool_mixer(u, w_pool, pool_scale):
    b, s, _ = u.shape
    uf = u.astype(jnp.float32).reshape(b, s, N_POOL_GROUPS, POOL_GROUP)
    cs = jnp.pad(jnp.cumsum(uf, axis=1), ((0, 0), (1, 0), (0, 0), (0, 0)))
    pos = jnp.arange(1, s + 1)
    pooled = []
    for gi, w in enumerate(POOL_WINDOWS):
        c = cs[:, :, gi]
        lag = jnp.pad(c, ((0, 0), (w, 0), (0, 0)))[:, : s + 1]
        win_sum = (c - lag)[:, 1:]
        cnt = jnp.minimum(pos, w).astype(jnp.float32)
        pooled.append(win_sum / cnt[None, :, None])
    pooled = jnp.stack(pooled, axis=2)
    diff = (pooled - uf).astype(u.dtype)
    y = jnp.einsum("bsgc,gcd->bsgd", diff, w_pool)
    return y.reshape(b, s, D_POOL) * pool_scale


def causal_depthwise_conv(u, w, bias):
    ch = u.shape[-1]
    y = lax.conv_general_dilated(
        u, w[:, None, :].astype(u.dtype), window_strides=(1,),
        padding=[(CONV_WIDTH - 1, 0)], dimension_numbers=("NWC", "WIO", "NWC"),
        feature_group_count=ch)
    return y + bias


def ssd_chunked(x, dt, a_neg, bm, cm):
    b, s, h, p = x.shape
    nc = s // CHUNK
    g, r = N_BC_GROUPS, HEADS_PER_GROUP
    xdt = (x.astype(jnp.float32) * dt[..., None]).reshape(b, nc, CHUNK, g, r, p)
    bc = bm.astype(jnp.float32).reshape(b, nc, CHUNK, g, D_STATE)
    cc = cm.astype(jnp.float32).reshape(b, nc, CHUNK, g, D_STATE)
    a = (dt * a_neg).reshape(b, nc, CHUNK, g, r).transpose(0, 3, 4, 1, 2)
    a_cs = jnp.cumsum(a, axis=-1)
    causal = jnp.tril(jnp.ones((CHUNK, CHUNK), dtype=bool))
    seg = a_cs[..., :, None] - a_cs[..., None, :]
    decay = jnp.exp(jnp.where(causal, seg, -jnp.inf))
    cb = jnp.einsum("bclgn,bcsgn->bcgls", cc, bc)
    y_diag = jnp.einsum("bcgls,bgrcls,bcsgrp->bclgrp", cb, decay, xdt)
    decay_to_end = jnp.exp(a_cs[..., -1:] - a_cs)
    states = jnp.einsum("bclgn,bgrcl,bclgrp->bcgrpn", bc, decay_to_end, xdt)
    chunk_decay = jnp.exp(a_cs[..., -1])

    def step(carry, inp):
        st, dec = inp
        return carry * dec[..., None, None] + st, carry

    h0 = jnp.zeros((b, g, r, p, D_STATE), jnp.float32)
    _, prev = lax.scan(step, h0, (jnp.moveaxis(states, 1, 0), jnp.moveaxis(chunk_decay, -1, 0)))
    y_off = jnp.einsum("bclgn,cbgrpn,bgrcl->bclgrp", cc, prev, jnp.exp(a_cs))
    return (y_diag + y_off).reshape(b, s, h, p)


def gated_rmsnorm(y, z, w):
    v = y.astype(jnp.float32) * jax.nn.silu(z.astype(jnp.float32))
    lead = v.shape[:-1]
    vg = v.reshape(*lead, N_BC_GROUPS, D_SSD // N_BC_GROUPS)
    vg = vg * lax.rsqrt(jnp.mean(jnp.square(vg), axis=-1, keepdims=True) + RMS_EPS)
    return vg.reshape(*lead, D_SSD) * w


def mixer_sublayer(x, w_in, w_pool, pool_scale, conv_w, conv_b, dt_bias, a_log,
                   d_skip, ssd_norm_w, w_out):
    b, s, _ = x.shape
    proj = x @ w_in
    u_pool, z, xbc, dt_raw = jnp.split(
        proj, [D_POOL, D_POOL + D_SSD, D_POOL + D_SSD + D_CONV], axis=-1)
    y_pool = pool_mixer(u_pool, w_pool, pool_scale)
    xbc = jax.nn.silu(causal_depthwise_conv(xbc, conv_w, conv_b))
    xs, bm, cm = jnp.split(xbc, [D_SSD, D_SSD + N_BC_GROUPS * D_STATE], axis=-1)
    xs = xs.reshape(b, s, N_SSD_HEADS, SSD_HEAD_DIM)
    bm = bm.reshape(b, s, N_BC_GROUPS, D_STATE)
    cm = cm.reshape(b, s, N_BC_GROUPS, D_STATE)
    dt = jax.nn.softplus(dt_raw.astype(jnp.float32) + dt_bias)
    a_neg = -jnp.exp(a_log.astype(jnp.float32))
    y = ssd_chunked(xs, dt, a_neg, bm, cm) + d_skip[:, None] * xs
    y_ssd = gated_rmsnorm(y.reshape(b, s, D_SSD), z, ssd_norm_w)
    mixed = jnp.concatenate([y_pool.astype(x.dtype), y_ssd.astype(x.dtype)], axis=-1)
    return mixed @ w_out


def setup_inputs(seed: int = 0) -> dict:
    key = jax.random.key(seed)
    ks = jax.random.split(key, 17)
    f32 = jnp.float32
    L = DEPTH
    nrm = lambda k, shp: jax.random.normal(k, shp, f32)
    x = nrm(ks[0], (BATCH, SEQ, D_MODEL))
    w_in = nrm(ks[1], (L, D_MODEL, D_IN_PROJ)) * D_MODEL ** -0.5
    w_pool = nrm(ks[2], (L, N_POOL_GROUPS, POOL_GROUP, POOL_GROUP)) * POOL_GROUP ** -0.5
    pool_scale = 1.0 + 0.02 * nrm(ks[3], (L, D_POOL))
    bound = CONV_WIDTH ** -0.5
    conv_w = jax.random.uniform(ks[4], (L, CONV_WIDTH, D_CONV), f32, -bound, bound)
    conv_b = jax.random.uniform(ks[5], (L, D_CONV), f32, -bound, bound)
    dt0 = jnp.exp(jax.random.uniform(ks[6], (L, N_SSD_HEADS), f32, math.log(1e-3), math.log(1e-1)))
    dt_bias = dt0 + jnp.log(-jnp.expm1(-dt0))
    a_log = jnp.log(jax.random.uniform(ks[7], (L, N_SSD_HEADS), f32, 1.0, 16.0))
    d_skip = 1.0 + 0.1 * nrm(ks[8], (L, N_SSD_HEADS))
    ssd_norm_w = 1.0 + 0.02 * nrm(ks[9], (L, D_SSD))
    w_out = nrm(ks[10], (L, D_MIX, D_MODEL)) * (D_MIX ** -0.5) * BETA
    ln1_g = 1.0 + 0.02 * nrm(ks[11], (L, D_MODEL))
    ln1_b = 0.02 * nrm(ks[12], (L, D_MODEL))
    w_ff1 = nrm(ks[13], (L, D_MODEL, D_FF)) * D_MODEL ** -0.5
    w_ff2 = nrm(ks[14], (L, D_FF, D_MODEL)) * (D_FF ** -0.5) * BETA
    ln2_g = 1.0 + 0.02 * nrm(ks[15], (L, D_MODEL))
    ln2_b = 0.02 * nrm(ks[16], (L, D_MODEL))
    return {"x": x, "w_in": w_in, "w_pool": w_pool, "pool_scale": pool_scale,
            "conv_w": conv_w, "conv_b": conv_b, "dt_bias": dt_bias, "a_log": a_log,
            "d_skip": d_skip, "ssd_norm_w": ssd_norm_w, "w_out": w_out,
            "ln1_g": ln1_g, "ln1_b": ln1_b, "w_ff1": w_ff1, "w_ff2": w_ff2,
            "ln2_g": ln2_g, "ln2_b": ln2_b}


def reference(x, w_in, w_pool, pool_scale, conv_w, conv_b, dt_bias, a_log, d_skip,
              ssd_norm_w, w_out, ln1_g, ln1_b, w_ff1, w_ff2, ln2_g, ln2_b):
    h = x
    for l in range(DEPTH):
        mix = mixer_sublayer(h, w_in[l], w_pool[l], pool_scale[l], conv_w[l], conv_b[l],
                             dt_bias[l], a_log[l], d_skip[l], ssd_norm_w[l], w_out[l])
        h = layer_norm(ALPHA * h + mix.astype(h.dtype), ln1_g[l], ln1_b[l])
        ff = jnp.square(jax.nn.relu(h @ w_ff1[l])) @ w_ff2[l]
        h = layer_norm(ALPHA * h + ff.astype(h.dtype), ln2_g[l], ln2_b[l])
    return h
```

```cpp
#include <hip/hip_runtime.h>
#include <hip/hip_cooperative_groups.h>
#include <cstdio>
namespace pg8 {
#define PG8_LAS __attribute__((address_space(3)))
typedef unsigned short bf16_t;
typedef short bf16x8 __attribute__((ext_vector_type(8)));
typedef float f32x4 __attribute__((ext_vector_type(4)));
typedef unsigned u32x4 __attribute__((ext_vector_type(4)));
constexpr int BM = 256, BK = 64, HALF = 128, HTB = HALF * BK * 2  , STAGE_BYTES = 8 * HTB, NXCD = 8, WGM = 8;

__host__ __device__ __forceinline__ int lds_byte(int r, int c) { const int st = (r >> 4) * 2 + (c >> 5), rr = r & 15, cc = c & 31, ob = rr * 64 + cc * 2; return st * 1024 + (ob ^ (((ob >> 9) & 1) << 5)); }
__host__ __device__ __forceinline__ void stage_rc(int b, int& R, int& C) { const int st = b / 1024, sb = b % 1024, swz = sb ^ (((sb >> 9) & 1) << 5); R = (st >> 1) * 16 + swz / 64; C = (st & 1) * 32 + (swz % 64) / 2; }
__host__ __device__ __forceinline__ int perm32(int rho) { const int n = rho >> 4, i = rho & 15; return 8 * (i >> 2) + 4 * n + (i & 3); }

struct Unit { int pm, pn; };
struct Gemm { const bf16_t* A; const bf16_t* Bt; int M, N, K; };

struct StaticOrder {
    int nM, nN, nwg, G, c;
    __host__ __device__ void init(int M, int N, int G_, int c_) { nM = M / BM; nN = N / BM; nwg = nM * nN; G = G_; c = c_; }
    __host__ __device__ bool next(int i, Unit& u) const {
        const long L = (long)i * G + c; if (L >= nwg) return false;
        int wgid = (int)L; { const int q = nwg / NXCD, r = nwg % NXCD, xcd = wgid % NXCD, off = wgid / NXCD; wgid = (xcd < r ? xcd * (q + 1) : r * (q + 1) + (xcd - r) * q) + off; }
        const int nig = WGM * nN, gid = wgid / nig, fm = gid * WGM, gsz = (nM - fm) < WGM ? (nM - fm) : WGM;
        u.pm = fm + ((wgid % nig) % gsz); u.pn = (wgid % nig) / gsz; return true;
    }
    __device__ __forceinline__ void a_ready(const Unit&) const {}
    __device__ __forceinline__ void done(const Unit&) const {}
};
struct CountedOrder : StaticOrder {
    const unsigned* ready; unsigned need; unsigned* tmo;
    __device__ __forceinline__ void a_ready(const Unit& u) const {
        if (threadIdx.x < 64) {
            const unsigned long long t0 = __builtin_amdgcn_s_memrealtime(); unsigned polls = 0;
            while ((unsigned)__builtin_amdgcn_readfirstlane(__hip_atomic_load(ready + 64 * u.pm, __ATOMIC_RELAXED, __HIP_MEMORY_SCOPE_AGENT)) < need) {
                if ((++polls & 255u) == 0u && __builtin_amdgcn_readfirstlane(__hip_atomic_load(tmo, __ATOMIC_RELAXED, __HIP_MEMORY_SCOPE_AGENT)) != 0u) break;
                if (__builtin_amdgcn_s_memrealtime() - t0 > 2000000ull) {
                    if (threadIdx.x == 0) { unsigned expect = 0u; __hip_atomic_compare_exchange_strong(tmo + 1, &expect, 0x600u | (unsigned)(u.pm & 0xff), __ATOMIC_RELAXED, __ATOMIC_RELAXED, __HIP_MEMORY_SCOPE_AGENT); __hip_atomic_store(tmo, 1u, __ATOMIC_RELAXED, __HIP_MEMORY_SCOPE_AGENT); }
                    break; }
                __builtin_amdgcn_s_sleep(2); }
            __builtin_amdgcn_fence(__ATOMIC_ACQUIRE, "agent");
            asm volatile("s_waitcnt vmcnt(0)" ::: "memory");
        }
#if !defined(BROKEN_HOOK_NO_BARRIER)
        asm volatile("" ::: "memory"); __builtin_amdgcn_s_barrier(); asm volatile("" ::: "memory");
#endif
    }
};

__device__ __forceinline__ unsigned cvt_pk_bf16(float lo, float hi) { unsigned r; asm volatile("v_cvt_pk_bf16_f32 %0, %1, %2" : "=v"(r) : "v"(lo), "v"(hi)); return r; }
typedef float f32x2 __attribute__((ext_vector_type(2)));
__device__ __forceinline__ f32x2 gelu_pk(f32x2 v) {
    const f32x2 av = __builtin_elementwise_abs(v), d = av * 0.2316418882f + 1.0f;
    f32x2 t; t.x = __builtin_amdgcn_rcpf(d.x); t.y = __builtin_amdgcn_rcpf(d.y);
    f32x2 q = t * 0.5307027145f + (-0.7265760135f); q = q * t + 0.7107068705f; q = q * t + (-0.142248368f); q = q * t + 0.127414796f; q = q * t;
    const f32x2 s = (v * v) * (-0.72134752044f);
    f32x2 e; e.x = __builtin_amdgcn_exp2f(s.x); e.y = __builtin_amdgcn_exp2f(s.y);
    const f32x2 m = v * (q * e), r = v - m;
    f32x2 o; o.x = v.x < 0.f ? m.x : r.x; o.y = v.y < 0.f ? m.y : r.y; return o;
}

struct EpiF32 {
    static constexpr bool PERM = false, AFTER_DRAIN = false;
    float* C; int ldc; const float* bias;
    __device__ __forceinline__ void operator()(const f32x4 (&acc)[2][2][4][2], const Unit& u, int wr, int wc, int fr, int fq) const {
        const int row0 = u.pm * BM + wr * 64 + fr, col0 = u.pn * BM + wc * 32 + 4 * fq;
        f32x4 bv[2][2];
#pragma unroll
        for (int bj = 0; bj < 2; ++bj)
#pragma unroll
            for (int n = 0; n < 2; ++n) bv[bj][n] = bias ? *(const f32x4*)(bias + col0 + bj * HALF + n * 16) : (f32x4){0.f, 0.f, 0.f, 0.f};
#pragma unroll
        for (int ai = 0; ai < 2; ++ai)
#pragma unroll
            for (int m = 0; m < 4; ++m) { float* rowp = C + (size_t)(row0 + ai * HALF + m * 16) * ldc + col0;
#pragma unroll
                for (int bj = 0; bj < 2; ++bj)
#pragma unroll
                    for (int n = 0; n < 2; ++n) *(f32x4*)(rowp + bj * HALF + n * 16) = acc[ai][bj][m][n] + bv[bj][n]; }
    }
};
template <int ACT  > struct EpiBf16 {
    static constexpr bool PERM = true, AFTER_DRAIN = false;
    bf16_t* O; int ldc; const float* bias; int split_cols; size_t split_stride;
    __device__ __forceinline__ void operator()(const f32x4 (&acc)[2][2][4][2], const Unit& u, int wr, int wc, int fr, int fq) const {
        const int row0 = u.pm * BM + wr * 64 + fr; int colt = u.pn * BM; bf16_t* base = O;
        if (split_cols) { const int t = colt / split_cols; base += (size_t)t * split_stride; colt -= t * split_cols; }
        const int col0 = colt + wc * 32 + 8 * fq, bcol0 = u.pn * BM + wc * 32 + 8 * fq;
        f32x4 bv[2][2];
#pragma unroll
        for (int bj = 0; bj < 2; ++bj)
#pragma unroll
            for (int n = 0; n < 2; ++n) bv[bj][n] = bias ? *(const f32x4*)(bias + bcol0 + bj * HALF + 4 * n) : (f32x4){0.f, 0.f, 0.f, 0.f};
#pragma unroll
        for (int ai = 0; ai < 2; ++ai)
#pragma unroll
            for (int m = 0; m < 4; ++m) { bf16_t* rowp = base + (size_t)(row0 + ai * HALF + m * 16) * ldc + col0;
#pragma unroll
                for (int bj = 0; bj < 2; ++bj) { f32x4 v0 = acc[ai][bj][m][0] + bv[bj][0], v1 = acc[ai][bj][m][1] + bv[bj][1];
                    if (ACT == 1) { f32x2 a = gelu_pk((f32x2){v0[0], v0[1]}), b = gelu_pk((f32x2){v0[2], v0[3]}), c = gelu_pk((f32x2){v1[0], v1[1]}), d = gelu_pk((f32x2){v1[2], v1[3]});
                        v0 = (f32x4){a.x, a.y, b.x, b.y}; v1 = (f32x4){c.x, c.y, d.x, d.y}; }
                    if (ACT == 2) {
#pragma unroll
                        for (int j = 0; j < 4; ++j) { v0[j] = 0.5f * v0[j] * (1.0f + erff(v0[j] * 0.70710678f)); v1[j] = 0.5f * v1[j] * (1.0f + erff(v1[j] * 0.70710678f)); } }
                    u32x4 w; w.x = cvt_pk_bf16(v0[0], v0[1]); w.y = cvt_pk_bf16(v0[2], v0[3]); w.z = cvt_pk_bf16(v1[0], v1[1]); w.w = cvt_pk_bf16(v1[2], v1[3]);
                    *(u32x4*)(rowp + bj * HALF) = w; } }
    }
};

struct PanelStats {
    unsigned* xbuf;
    unsigned* cnt;
    unsigned* tmo;
    int ntn; float eps;
    unsigned code;
    __device__ __forceinline__ bool run(const f32x4 (&v)[2][2][4][2], const Unit& u, int wr, int wc, int fr, int fq, PG8_LAS unsigned char* lds, int wid, int lane) const {
        typedef float f32x2v __attribute__((ext_vector_type(2)));
        PG8_LAS f32x2v* P = (PG8_LAS f32x2v*)lds;
        PG8_LAS f32x2v* S = (PG8_LAS f32x2v*)(lds + 8192);
        PG8_LAS unsigned* flag = (PG8_LAS unsigned*)(lds + 8192 + 2048);
#pragma unroll
        for (int ai = 0; ai < 2; ++ai)
#pragma unroll
            for (int m = 0; m < 4; ++m) {
                float s = 0.f;
#pragma unroll
                for (int bj = 0; bj < 2; ++bj)
#pragma unroll
                    for (int n = 0; n < 2; ++n) { const f32x4 x = v[ai][bj][m][n]; s += (x[0] + x[1]) + (x[2] + x[3]); }
                s += __shfl_xor(s, 16); s += __shfl_xor(s, 32);
                const float mw = s * (1.0f / 64.0f); float q = 0.f;
#pragma unroll
                for (int bj = 0; bj < 2; ++bj)
#pragma unroll
                    for (int n = 0; n < 2; ++n) { const f32x4 d = v[ai][bj][m][n] - mw; q += (d[0] * d[0] + d[1] * d[1]) + (d[2] * d[2] + d[3] * d[3]); }
                q += __shfl_xor(q, 16); q += __shfl_xor(q, 32);
                if (fq == 0) P[(ai * HALF + wr * 64 + m * 16 + fr) * 4 + wc] = (f32x2v){mw, q};
            }
        asm volatile("s_waitcnt lgkmcnt(0)" ::: "memory"); __builtin_amdgcn_s_barrier(); asm volatile("" ::: "memory");
#if defined(BROKEN_NO_WAIT)
        if (blockIdx.x >= 64) { const long long t0 = clock64(); while (clock64() - t0 < 60000) __builtin_amdgcn_s_sleep(8); }
#endif
        const int row = wid * 32 + (lane & 31);
        if (lane < 32) {
            const f32x2v a = P[row * 4 + 0], b = P[row * 4 + 1], c = P[row * 4 + 2], d = P[row * 4 + 3];
            const float mt = (a.x + b.x + c.x + d.x) * 0.25f;
            const float da = a.x - mt, db = b.x - mt, dc = c.x - mt, dd = d.x - mt;
            const float m2 = (a.y + b.y) + (c.y + d.y) + 64.0f * ((da * da + db * db) + (dc * dc + dd * dd));
            unsigned long long* slot = (unsigned long long*)xbuf + ((size_t)(u.pm * BM + row) * 4 + u.pn);
            __hip_atomic_store(slot, ((unsigned long long)__float_as_uint(m2) << 32) | __float_as_uint(mt), __ATOMIC_RELAXED, __HIP_MEMORY_SCOPE_AGENT);
        }
        asm volatile("s_waitcnt vmcnt(0)" ::: "memory");
        if (lane == 0) __hip_atomic_fetch_add(cnt + 64 * u.pm, 1u, __ATOMIC_RELAXED, __HIP_MEMORY_SCOPE_AGENT);
        if (wid == 0) {
            bool dead = false; const unsigned long long t0 = __builtin_amdgcn_s_memrealtime(); const unsigned want = 8u * (unsigned)ntn;
            for (;;) {
#if defined(BROKEN_NO_WAIT)
                break;
#endif
                if ((unsigned)__builtin_amdgcn_readfirstlane(__hip_atomic_load(cnt + 64 * u.pm, __ATOMIC_RELAXED, __HIP_MEMORY_SCOPE_AGENT)) >= want) break;
                if (__builtin_amdgcn_s_memrealtime() - t0 > 2000000ull) {
                    if (lane == 0) { unsigned expect = 0u; __hip_atomic_compare_exchange_strong(tmo + 1, &expect, code | (unsigned)(u.pm & 0xff), __ATOMIC_RELAXED, __ATOMIC_RELAXED, __HIP_MEMORY_SCOPE_AGENT);
                                     __hip_atomic_store(tmo, 1u, __ATOMIC_RELAXED, __HIP_MEMORY_SCOPE_AGENT); }
                    dead = true; break; }
                __builtin_amdgcn_s_sleep(2);
            }
            __builtin_amdgcn_fence(__ATOMIC_ACQUIRE, "agent");
            if (lane == 0) flag[0] = dead ? 1u : 0u;
        }
        asm volatile("s_waitcnt vmcnt(0) lgkmcnt(0)" ::: "memory"); __builtin_amdgcn_s_barrier(); asm volatile("" ::: "memory");
        const bool bad = flag[0] != 0u;
        if (lane < 32) {
            const unsigned long long* slot = (const unsigned long long*)xbuf + (size_t)(u.pm * BM + row) * 4; float mt[4], m2[4]; float ms = 0.f;
#pragma unroll
            for (int t = 0; t < 4; ++t) { if (t < ntn) { const unsigned long long w = __hip_atomic_load(slot + t, __ATOMIC_RELAXED, __HIP_MEMORY_SCOPE_AGENT); mt[t] = __uint_as_float((unsigned)w); m2[t] = __uint_as_float((unsigned)(w >> 32)); } else { mt[t] = 0.f; m2[t] = 0.f; } ms += mt[t]; }
            const float mean = ms / (float)ntn; float q = 0.f;
#pragma unroll
            for (int t = 0; t < 4; ++t) if (t < ntn) { const float dm = mt[t] - mean; q += m2[t] + 256.0f * dm * dm; }
            S[row] = (f32x2v){mean, 1.0f / sqrtf(q / (256.0f * (float)ntn) + eps)};
        }
        asm volatile("s_waitcnt lgkmcnt(0)" ::: "memory"); __builtin_amdgcn_s_barrier(); asm volatile("" ::: "memory");
        return bad;
    }
};
struct EpiLnRes {
    static constexpr bool PERM = false, AFTER_DRAIN = true;
    const float* base; float* out; int ldc; const float* bias; PanelStats st; unsigned poison;
    __device__ __forceinline__ void refuse(size_t i0, size_t stride, int M, int N) const { const float q = __builtin_nanf(""); for (size_t i = i0; i < (size_t)M * N; i += stride) out[(i / N) * ldc + i % N] = q;
        if (i0 == 0) { unsigned expect = 0u; __hip_atomic_compare_exchange_strong(st.tmo + 1, &expect, 0x7f0u, __ATOMIC_RELAXED, __ATOMIC_RELAXED, __HIP_MEMORY_SCOPE_AGENT); __hip_atomic_store(st.tmo, 1u, __ATOMIC_RELAXED, __HIP_MEMORY_SCOPE_AGENT); } }
    __device__ __forceinline__ void fused(f32x4 (&acc)[2][2][4][2], const Unit& u, int wr, int wc, int fr, int fq, PG8_LAS unsigned char* lds, int wid, int lane) const {
        typedef float f32x2v __attribute__((ext_vector_type(2)));
        const PG8_LAS f32x2v* S = (const PG8_LAS f32x2v*)(lds + 8192);
        const int col0 = u.pn * BM + wc * 32 + 4 * fq;
#pragma unroll
        for (int bj = 0; bj < 2; ++bj)
#pragma unroll
            for (int n = 0; n < 2; ++n) { const f32x4 bv = bias ? *(const f32x4*)(bias + col0 + bj * HALF + n * 16) : (f32x4){0.f, 0.f, 0.f, 0.f};
#pragma unroll
                for (int ai = 0; ai < 2; ++ai)
#pragma unroll
                    for (int m = 0; m < 4; ++m) acc[ai][bj][m][n] += bv; }
        const bool bad = st.run(acc, u, wr, wc, fr, fq, lds, wid, lane) || poison != 0u;
        const float qnan = __builtin_nanf("");
#pragma unroll
        for (int ai = 0; ai < 2; ++ai)
#pragma unroll
            for (int m = 0; m < 4; ++m) { const int r = ai * HALF + wr * 64 + m * 16 + fr; const f32x2v sr = S[r]; const size_t off = (size_t)(u.pm * BM + r) * ldc + col0;
#pragma unroll
                for (int bj = 0; bj < 2; ++bj)
#pragma unroll
                    for (int n = 0; n < 2; ++n) { const f32x4 bs = *(const f32x4*)(base + off + bj * HALF + n * 16); f32x4 o = bs + (acc[ai][bj][m][n] - sr.x) * sr.y;
                        if (bad) o = (f32x4){qnan, qnan, qnan, qnan}; *(f32x4*)(out + off + bj * HALF + n * 16) = o; }
                asm volatile("" ::: "memory"); }
    }
};
struct EpiLnResLn {
    static constexpr bool PERM = false, AFTER_DRAIN = true;
    const float* base; float* out; bf16_t* xn; int ldc; const float* bias; PanelStats st1, st2; unsigned poison;
    __device__ __forceinline__ void refuse(size_t i0, size_t stride, int M, int N) const { const float q = __builtin_nanf(""); for (size_t i = i0; i < (size_t)M * N; i += stride) { const size_t o = (i / N) * ldc + i % N; out[o] = q; xn[o] = (bf16_t)0x7fc0u; }
        if (i0 == 0) { unsigned expect = 0u; __hip_atomic_compare_exchange_strong(st1.tmo + 1, &expect, 0x7f0u, __ATOMIC_RELAXED, __ATOMIC_RELAXED, __HIP_MEMORY_SCOPE_AGENT); __hip_atomic_store(st1.tmo, 1u, __ATOMIC_RELAXED, __HIP_MEMORY_SCOPE_AGENT); } }
    __device__ __forceinline__ void fused(f32x4 (&acc)[2][2][4][2], const Unit& u, int wr, int wc, int fr, int fq, PG8_LAS unsigned char* lds, int wid, int lane) const {
        typedef float f32x2v __attribute__((ext_vector_type(2))); typedef unsigned u32x2v __attribute__((ext_vector_type(2)));
        const PG8_LAS f32x2v* S = (const PG8_LAS f32x2v*)(lds + 8192);
        const int col0 = u.pn * BM + wc * 32 + 4 * fq;
#pragma unroll
        for (int bj = 0; bj < 2; ++bj)
#pragma unroll
            for (int n = 0; n < 2; ++n) { const f32x4 bv = bias ? *(const f32x4*)(bias + col0 + bj * HALF + n * 16) : (f32x4){0.f, 0.f, 0.f, 0.f};
#pragma unroll
                for (int ai = 0; ai < 2; ++ai)
#pragma unroll
                    for (int m = 0; m < 4; ++m) acc[ai][bj][m][n] += bv; }
        bool bad = st1.run(acc, u, wr, wc, fr, fq, lds, wid, lane) || poison != 0u;
        const float qnan = __builtin_nanf("");
#pragma unroll
        for (int ai = 0; ai < 2; ++ai)
#pragma unroll
            for (int m = 0; m < 4; ++m) { const int r = ai * HALF + wr * 64 + m * 16 + fr; const f32x2v sr = S[r]; const size_t off = (size_t)(u.pm * BM + r) * ldc + col0;
#pragma unroll
                for (int bj = 0; bj < 2; ++bj)
#pragma unroll
                    for (int n = 0; n < 2; ++n) { const f32x4 bs = *(const f32x4*)(base + off + bj * HALF + n * 16); acc[ai][bj][m][n] = bs + (acc[ai][bj][m][n] - sr.x) * sr.y; }
                asm volatile("" : "+v"(acc[ai][0][m][0]), "+v"(acc[ai][0][m][1]), "+v"(acc[ai][1][m][0]), "+v"(acc[ai][1][m][1]));
                if (m & 1) asm volatile("" ::: "memory"); }
        const bool bad1 = bad;
        bad = st2.run(acc, u, wr, wc, fr, fq, lds, wid, lane) || bad;
#pragma unroll
        for (int ai = 0; ai < 2; ++ai)
#pragma unroll
            for (int m = 0; m < 4; ++m) { const int r = ai * HALF + wr * 64 + m * 16 + fr; const f32x2v sr = S[r]; const size_t off = (size_t)(u.pm * BM + r) * ldc + col0;
#pragma unroll
                for (int bj = 0; bj < 2; ++bj)
#pragma unroll
                    for (int n = 0; n < 2; ++n) { const f32x4 x1 = acc[ai][bj][m][n]; *(f32x4*)(out + off + bj * HALF + n * 16) = bad1 ? (f32x4){qnan, qnan, qnan, qnan} : x1;
                        const f32x4 o = (x1 - sr.x) * sr.y; u32x2v w; w.x = cvt_pk_bf16(o[0], o[1]); w.y = cvt_pk_bf16(o[2], o[3]);
                        if (bad) { w.x = 0x7fc07fc0u; w.y = 0x7fc07fc0u; } *(u32x2v*)(xn + off + bj * HALF + n * 16) = w; }
                asm volatile("" ::: "memory"); }
    }
};

template <class Epi, class Sched, bool STAMP = false>
__device__ __forceinline__ void gemm_phase(PG8_LAS unsigned char* lds, const Gemm g, const Sched& S, const Epi& E, unsigned long long* stamps) {
    int tid_ = threadIdx.x; asm volatile("" : "+v"(tid_));
    const int tid = tid_, wid = __builtin_amdgcn_readfirstlane(tid >> 6), lane = tid & 63, wr = wid >> 2, wc = wid & 3, fr = lane & 15, fq = lane >> 4;
    const int K = g.K, nt = K / BK;
    int ts_lo = 0, ts_hi = 0, nts = 0; const unsigned long long rt_entry = STAMP ? (unsigned long long)wall_clock64() : 0ull;
#define PG8_STAMP() do { if (STAMP && wid == 0 && nts < 64) { const unsigned long long _c = (unsigned long long)clock64(); \
        ts_lo = (lane == nts) ? (int)(unsigned)_c : ts_lo; ts_hi = (lane == nts) ? (int)(unsigned)(_c >> 32) : ts_hi; ++nts; } } while (0)
    PG8_STAMP();
    unsigned voffA[2], voffB[2];
#pragma unroll
    for (int i = 0; i < 2; ++i) { int R, C; stage_rc(tid * 16 + i * 8192, R, C); const int Rb = Epi::PERM ? ((R & ~31) + perm32(R & 31)) : R;
        voffA[i] = (unsigned)(R * K + C) * 2u; voffB[i] = (unsigned)(Rb * K + C) * 2u; }
    const size_t kstep = (size_t)(BK * 2);
    const size_t hstep = (size_t)HALF * K * 2;
    const size_t tstep = 2 * hstep;
    const unsigned ldsw = (unsigned)wid * 1024u;
    const int aoff = lds_byte(wr * 64 + fr, fq * 8), boff = lds_byte(wc * 32 + fr, fq * 8);
#define PG8_SA(b, h) (((b) * 2 + (h)) * HTB)
#define PG8_SB(b, h) ((4 + (b) * 2 + (h)) * HTB)
#define PG8_STAGE(bufoff, gbase, voff) do { _Pragma("unroll") for (int _i = 0; _i < 2; ++_i) \
        __builtin_amdgcn_global_load_lds((const unsigned*)((const char*)(gbase) + (voff)[_i]), (PG8_LAS unsigned*)(lds + (bufoff) + ldsw + _i * 8192), 16, 0, 0); } while (0)
#define PG8_LDA(dst, b, h) do { _Pragma("unroll") for (int m = 0; m < 4; ++m) _Pragma("unroll") for (int k = 0; k < 2; ++k) dst[m][k] = *(const PG8_LAS bf16x8*)(lds + PG8_SA(b, h) + aoff + m * 2048 + k * 1024); } while (0)
#define PG8_LDB(dst, b, h) do { _Pragma("unroll") for (int n = 0; n < 2; ++n) _Pragma("unroll") for (int k = 0; k < 2; ++k) dst[n][k] = *(const PG8_LAS bf16x8*)(lds + PG8_SB(b, h) + boff + n * 2048 + k * 1024); } while (0)
#define PG8_MMA(ai, bj, At, Bt) do { __builtin_amdgcn_s_setprio(1); _Pragma("unroll") for (int m = 0; m < 4; ++m) _Pragma("unroll") for (int n = 0; n < 2; ++n) _Pragma("unroll") for (int k = 0; k < 2; ++k) \
        acc[ai][bj][m][n] = __builtin_amdgcn_mfma_f32_16x16x32_bf16(Bt[n][k], At[m][k], acc[ai][bj][m][n], 0, 0, 0); __builtin_amdgcn_s_setprio(0); } while (0)
#define PG8_WAIT_V(n) asm volatile("s_waitcnt vmcnt(" #n ")" ::: "memory")
#define PG8_WAIT_L(n) asm volatile("s_waitcnt lgkmcnt(" #n ")" ::: "memory")
#define PG8_BAR __builtin_amdgcn_s_barrier()
#define PG8_SCHED __builtin_amdgcn_sched_barrier(0)
    Unit cur, nxt; int ui = 0;
    if (!S.next(0, cur)) return;
    f32x4 acc[2][2][4][2];
#pragma unroll
    for (int a = 0; a < 2; ++a)
#pragma unroll
        for (int b = 0; b < 2; ++b)
#pragma unroll
            for (int m = 0; m < 4; ++m)
#pragma unroll
                for (int n = 0; n < 2; ++n) acc[a][b][m][n] = (f32x4){0.f, 0.f, 0.f, 0.f};
    bf16x8 At[4][2], B0[2][2], B1[2][2];
    const char* cA = (const char*)g.A + (size_t)cur.pm * tstep; const char* cB = (const char*)g.Bt + (size_t)cur.pn * tstep;
    S.a_ready(cur);
    PG8_STAGE(PG8_SB(0, 0), cB, voffB); PG8_STAGE(PG8_SA(0, 0), cA, voffA); PG8_STAGE(PG8_SB(0, 1), cB + hstep, voffB); PG8_STAGE(PG8_SA(0, 1), cA + hstep, voffA);
    if (wr == 1) PG8_BAR;
    PG8_WAIT_V(4); PG8_BAR;
    PG8_STAGE(PG8_SB(1, 0), cB + kstep, voffB); PG8_STAGE(PG8_SA(1, 0), cA + kstep, voffA); PG8_STAGE(PG8_SB(1, 1), cB + hstep + kstep, voffB);
    PG8_WAIT_V(6); PG8_BAR;
    PG8_STAMP();
    for (;;) {
        const bool has_next = S.next(ui + 1, nxt);
        const char* nA = has_next ? (const char*)g.A + (size_t)nxt.pm * tstep : cA; const char* nB = has_next ? (const char*)g.Bt + (size_t)nxt.pn * tstep : cB;
        for (int t = 0; t < nt; t += 2) {
            const bool last = (t == nt - 2);
            const char* a1 = cA + (size_t)(t + 1) * kstep;
            const char* a2 = last ? nA : cA + (size_t)(t + 2) * kstep; const char* b2 = last ? nB : cB + (size_t)(t + 2) * kstep;
            const char* a3 = a2 + kstep; const char* b3 = b2 + kstep;
            if (last && has_next) S.a_ready(nxt);
            PG8_LDB(B0, 0, 0); PG8_SCHED; PG8_LDA(At, 0, 0); PG8_STAGE(PG8_SA(1, 1), a1 + hstep, voffA);
            PG8_WAIT_L(8); PG8_BAR; PG8_WAIT_L(0); PG8_MMA(0, 0, At, B0); PG8_BAR; PG8_SCHED;
            PG8_LDB(B1, 0, 1); PG8_STAGE(PG8_SB(0, 0), b2, voffB);
            PG8_BAR; PG8_WAIT_L(0); PG8_MMA(0, 1, At, B1); PG8_BAR;
            PG8_LDA(At, 0, 1); PG8_STAGE(PG8_SA(0, 0), a2, voffA);
            PG8_BAR; PG8_WAIT_L(0); PG8_MMA(1, 0, At, B0); PG8_BAR; PG8_SCHED;
            PG8_STAGE(PG8_SB(0, 1), b2 + hstep, voffB);
            PG8_WAIT_V(6); PG8_BAR; PG8_MMA(1, 1, At, B1); PG8_BAR;
            PG8_LDB(B0, 1, 0); PG8_SCHED; PG8_LDA(At, 1, 0); PG8_STAGE(PG8_SA(0, 1), a2 + hstep, voffA);
            PG8_WAIT_L(8); PG8_BAR; PG8_WAIT_L(0); PG8_MMA(0, 0, At, B0); PG8_BAR; PG8_SCHED;
            PG8_LDB(B1, 1, 1); PG8_STAGE(PG8_SB(1, 0), b3, voffB);
            PG8_BAR; PG8_WAIT_L(0); PG8_MMA(0, 1, At, B1); PG8_BAR;
            PG8_LDA(At, 1, 1); PG8_STAGE(PG8_SA(1, 0), a3, voffA);
            PG8_BAR; PG8_WAIT_L(0); PG8_MMA(1, 0, At, B0); PG8_BAR; PG8_SCHED;
            PG8_STAGE(PG8_SB(1, 1), b3 + hstep, voffB);
            PG8_WAIT_V(6); PG8_BAR; PG8_MMA(1, 1, At, B1); PG8_BAR;
        }
        PG8_STAMP();
        if constexpr (!Epi::AFTER_DRAIN) { E(acc, cur, wr, wc, fr, fq); S.done(cur); }
        PG8_STAMP();
        if (!has_next) break;
#pragma unroll
        for (int a = 0; a < 2; ++a)
#pragma unroll
            for (int b = 0; b < 2; ++b)
#pragma unroll
                for (int m = 0; m < 4; ++m)
#pragma unroll
                    for (int n = 0; n < 2; ++n) acc[a][b][m][n] = (f32x4){0.f, 0.f, 0.f, 0.f};
        cur = nxt; cA = nA; cB = nB; ++ui;
    }
    PG8_WAIT_V(0);
    if (wr == 0) PG8_BAR;
    PG8_BAR;
    if constexpr (Epi::AFTER_DRAIN) { E.fused(acc, cur, wr, wc, fr, fq, lds, wid, lane); S.done(cur); }
    PG8_STAMP();
    if (STAMP && wid == 0) { stamps[lane] = lane < nts ? (((unsigned long long)(unsigned)ts_hi << 32) | (unsigned)ts_lo) : 0ull;
        if (lane == 62) stamps[62] = rt_entry; if (lane == 63) stamps[63] = (unsigned long long)wall_clock64(); }
#undef PG8_STAMP
#undef PG8_SA
#undef PG8_SB
#undef PG8_STAGE
#undef PG8_LDA
#undef PG8_LDB
#undef PG8_MMA
#undef PG8_WAIT_V
#undef PG8_WAIT_L
#undef PG8_BAR
#undef PG8_SCHED
}
}

namespace cg = cooperative_groups;
namespace mk {
#define LAS __attribute__((address_space(3)))
typedef unsigned short bf16_t;
typedef short bf16x8 __attribute__((ext_vector_type(8)));
typedef float f32x4 __attribute__((ext_vector_type(4)));
typedef float f32x2 __attribute__((ext_vector_type(2)));
typedef unsigned u32x4 __attribute__((ext_vector_type(4)));
typedef unsigned u32x2 __attribute__((ext_vector_type(2)));

constexpr int SEQ = 2048, MTOK = 32768, DM = 1024, DFF = 4096, DMIX = 2048;
constexpr int NPROJ = 4608, DINP = 4632, NH = 24;
constexpr float ALPHA = 1.189207115002721f, LN_EPS = 1e-5f, RMS_EPS = 1e-5f;
constexpr int NTHREADS = 512;
constexpr int LDS_BYTES = 158720;

constexpr size_t WS_WIN   = 0;
constexpr size_t WS_WOUT  = WS_WIN   + 4608ull * 1024 * 2;
constexpr size_t WS_WFF1  = WS_WOUT  + 1024ull * 2048 * 2;
constexpr size_t WS_WFF2  = WS_WFF1  + 4096ull * 1024 * 2;
constexpr size_t WS_WPOOL = WS_WFF2  + 4096ull * 1024 * 2;
constexpr size_t WS_DT    = WS_WPOOL + 4ull * 128 * 128 * 2;
constexpr size_t WS_SSQ   = WS_DT    + 16ull * 24 * 2048 * 4;
constexpr size_t WS_UZ    = WS_SSQ   + 32768ull * 24 * 4;
constexpr size_t WS_XBC   = WS_UZ    + 32768ull * 2048 * 2;
constexpr size_t WS_BT    = WS_XBC   + 32768ull * 2560 * 2;
constexpr size_t WS_BC    = WS_BT    + 16ull * 512 * 2048 * 2;
constexpr size_t WS_END   = WS_BC    + 32768ull * 1024 * 2;
constexpr size_t WS_H1    = WS_UZ;
constexpr size_t WS_HB    = WS_BT;

struct Params { const float* in[17]; float* out; unsigned char* ws; int ph_lo, ph_hi; };

__device__ __forceinline__ unsigned pk_bf16(float lo, float hi) { unsigned r; asm("v_cvt_pk_bf16_f32 %0, %1, %2" : "=v"(r) : "v"(lo), "v"(hi)); return r; }
__device__ __forceinline__ float bf_lo(unsigned u) { return __uint_as_float(u << 16); }
__device__ __forceinline__ float bf_hi(unsigned u) { return __uint_as_float(u & 0xffff0000u); }
__device__ __forceinline__ bf16_t f2bf(float f) { return (bf16_t)(pk_bf16(f, 0.f) & 0xffffu); }
__device__ __forceinline__ bf16x8 as_bf16x8(u32x4 v) { union { u32x4 u; bf16x8 b; } c; c.u = v; return c.b; }
__device__ __forceinline__ f32x4 mfma16(bf16x8 a, bf16x8 b, f32x4 c) { return __builtin_amdgcn_mfma_f32_16x16x32_bf16(a, b, c, 0, 0, 0); }
__device__ __forceinline__ float silu(float v) { return v / (1.0f + __expf(-v)); }
__device__ __forceinline__ float softplus(float v) { return fmaxf(v, 0.f) + log1pf(__expf(-fabsf(v))); }

constexpr int PT = 136;
__device__ __forceinline__ bf16x8 ldfrag(const LAS bf16_t* base, int row, int k) { return *(const LAS bf16x8*)(base + row * PT + k); }

__device__ __forceinline__ void transpose_tile(const float* src, int ldsrc, bf16_t* dst, int lddst, int k0, int n0, LAS float* tile, int tid) {
    { const int i = tid >> 4, j4 = (tid & 15) * 4;
#pragma unroll
      for (int h = 0; h < 2; ++h) { const f32x4 v = *(const f32x4*)(src + (size_t)(k0 + i + 32 * h) * ldsrc + n0 + j4);
          tile[(i + 32 * h) * 65 + j4 + 0] = v[0]; tile[(i + 32 * h) * 65 + j4 + 1] = v[1]; tile[(i + 32 * h) * 65 + j4 + 2] = v[2]; tile[(i + 32 * h) * 65 + j4 + 3] = v[3]; } }
    __syncthreads();
    { const int n = tid >> 3, kk = (tid & 7) * 8; float e[8];
#pragma unroll
      for (int t = 0; t < 8; ++t) e[t] = tile[(kk + t) * 65 + n];
      u32x4 o; o.x = pk_bf16(e[0], e[1]); o.y = pk_bf16(e[2], e[3]); o.z = pk_bf16(e[4], e[5]); o.w = pk_bf16(e[6], e[7]);
      *(u32x4*)(dst + (size_t)(n0 + n) * lddst + k0 + kk) = o; }
    __syncthreads();
}

__device__ __forceinline__ void phase0(const Params& P, LAS unsigned char* lds) {
    int tid_ = threadIdx.x; asm volatile("" : "+v"(tid_)); const int tid = tid_, lane = tid & 63, wid = tid >> 6, r = lane & 15, q = lane >> 4;
    const float* x = P.in[0]; const float* w_in = P.in[1];
    bf16_t* xb = (bf16_t*)P.out;
    LAS bf16_t* sW = (LAS bf16_t*)lds;
    for (int i = tid; i < 32 * 1024; i += NTHREADS) { const int k = i >> 5, h = i & 31; const float v = h < NH ? w_in[(size_t)k * DINP + NPROJ + h] : 0.f; sW[h * 1032 + k] = f2bf(v); }
    __syncthreads();
    float* dt = (float*)(P.ws + WS_DT);
    for (int grp = blockIdx.x * 8 + wid; grp < MTOK / 16; grp += gridDim.x * 8) {
        const int row0 = grp * 16;
        const float* xr = x + (size_t)(row0 + r) * DM + 8 * q;
        bf16_t* xo = xb + (size_t)(row0 + r) * DM + 8 * q;
        f32x4 a0 = {0.f, 0.f, 0.f, 0.f}, a1 = {0.f, 0.f, 0.f, 0.f};
#pragma unroll 4
        for (int k0 = 0; k0 < DM; k0 += 32) {
            const f32x4 v0 = *(const f32x4*)(xr + k0), v1 = *(const f32x4*)(xr + k0 + 4);
            u32x4 pk; pk.x = pk_bf16(v0[0], v0[1]); pk.y = pk_bf16(v0[2], v0[3]); pk.z = pk_bf16(v1[0], v1[1]); pk.w = pk_bf16(v1[2], v1[3]);
            *(u32x4*)(xo + k0) = pk;
            const bf16x8 af = as_bf16x8(pk);
            const bf16x8 b0 = *(const LAS bf16x8*)(sW + r * 1032 + k0 + 8 * q), b1 = *(const LAS bf16x8*)(sW + (16 + r) * 1032 + k0 + 8 * q);
            a0 = mfma16(af, b0, a0); a1 = mfma16(af, b1, a1);
        }
        const int b = row0 >> 11, pos = (row0 & 2047) + 4 * q;
        *(f32x4*)(dt + (size_t)(b * NH + r) * SEQ + pos) = a0;
        if (r < 8) *(f32x4*)(dt + (size_t)(b * NH + 16 + r) * SEQ + pos) = a1;
    }
    LAS float* tile = (LAS float*)(lds + 69632);
    unsigned char* ws = P.ws;
    const int n0j = 16 * 72, n1j = 32 * 16, n2j = 16 * 64, n3j = 64 * 16, total = n0j + n1j + n2j + n3j + 16;
    for (int t = blockIdx.x; t < total; t += gridDim.x) {
        int u = t;
        if (u < n0j) { transpose_tile(P.in[1], DINP, (bf16_t*)(ws + WS_WIN), 1024, (u / 72) * 64, (u % 72) * 64, tile, tid); continue; }
        u -= n0j;
        if (u < n1j) { transpose_tile(P.in[10], 1024, (bf16_t*)(ws + WS_WOUT), 2048, (u / 16) * 64, (u % 16) * 64, tile, tid); continue; }
        u -= n1j;
        if (u < n2j) { transpose_tile(P.in[13], 4096, (bf16_t*)(ws + WS_WFF1), 1024, (u / 64) * 64, (u % 64) * 64, tile, tid); continue; }
        u -= n2j;
        if (u < n3j) { transpose_tile(P.in[14], 1024, (bf16_t*)(ws + WS_WFF2), 4096, (u / 16) * 64, (u % 16) * 64, tile, tid); continue; }
        u -= n3j;
        { const int g = u >> 2, tt = u & 3; transpose_tile(P.in[2] + (size_t)g * 16384, 128, (bf16_t*)(ws + WS_WPOOL) + (size_t)g * 16384, 128, (tt >> 1) * 64, (tt & 1) * 64, tile, tid); }
    }
}

__device__ __forceinline__ void phase_conv(const Params& P) {
    int tid_ = threadIdx.x; asm volatile("" : "+v"(tid_)); const int tid = tid_, lane = tid & 63, wid = tid >> 6;
    const bf16_t* xbc = (const bf16_t*)(P.ws + WS_XBC);
    bf16_t* BC = (bf16_t*)(P.ws + WS_BC); bf16_t* BT = (bf16_t*)(P.ws + WS_BT); bf16_t* XT = (bf16_t*)P.out;
    const float* conv_w = P.in[4]; const float* conv_b = P.in[5];
    const int nW = gridDim.x * 8;
    for (int item = blockIdx.x * 8 + wid; item < 5 * 1024; item += nW) {
        const int cs = item % 5, tb = item / 5, t0 = tb * 32, b = t0 >> 11, pos0 = t0 & 2047;
        const int c0 = cs * 512 + lane * 8;
        float w0[8], w1[8], w2[8], w3[8], bi[8], p3[8], p2[8], p1[8];
        { const f32x4 a = *(const f32x4*)(conv_w + c0), bq = *(const f32x4*)(conv_w + c0 + 4);
          const f32x4 c = *(const f32x4*)(conv_w + 2560 + c0), d = *(const f32x4*)(conv_w + 2560 + c0 + 4);
          const f32x4 e = *(const f32x4*)(conv_w + 5120 + c0), f = *(const f32x4*)(conv_w + 5120 + c0 + 4);
          const f32x4 g = *(const f32x4*)(conv_w + 7680 + c0), h = *(const f32x4*)(conv_w + 7680 + c0 + 4);
          const f32x4 bb0 = *(const f32x4*)(conv_b + c0), bb1 = *(const f32x4*)(conv_b + c0 + 4);
#pragma unroll
          for (int j = 0; j < 4; ++j) { w0[j] = a[j]; w0[j + 4] = bq[j]; w1[j] = c[j]; w1[j + 4] = d[j]; w2[j] = e[j]; w2[j + 4] = f[j]; w3[j] = g[j]; w3[j + 4] = h[j]; bi[j] = bb0[j]; bi[j + 4] = bb1[j]; } }
        const bf16_t* src = xbc + (size_t)t0 * 2560 + c0;
        if (pos0 == 0) {
#pragma unroll
            for (int j = 0; j < 8; ++j) { p3[j] = 0.f; p2[j] = 0.f; p1[j] = 0.f; }
        } else {
            const u32x4 r3 = *(const u32x4*)(src - 3 * 2560), r2 = *(const u32x4*)(src - 2 * 2560), r1 = *(const u32x4*)(src - 2560);
#pragma unroll
            for (int j = 0; j < 4; ++j) { p3[2 * j] = bf_lo(r3[j]); p3[2 * j + 1] = bf_hi(r3[j]); p2[2 * j] = bf_lo(r2[j]); p2[2 * j + 1] = bf_hi(r2[j]); p1[2 * j] = bf_lo(r1[j]); p1[2 * j + 1] = bf_hi(r1[j]); }
        }
        bf16_t* dstT = nullptr;
        if (cs < 3) dstT = XT + ((size_t)b * 1536 + c0) * SEQ + pos0; else if (cs == 3) dstT = BT + ((size_t)b * 512 + (c0 - 1536)) * SEQ + pos0;
        bf16_t* dstR = BC + (size_t)t0 * 1024 + (cs - 3) * 512 + lane * 8;
        for (int t8 = 0; t8 < 4; ++t8) {
            unsigned tr[8][4]; float ev[8];
#pragma unroll
            for (int tk = 0; tk < 8; ++tk) {
                const u32x4 rw = *(const u32x4*)(src + (size_t)(t8 * 8 + tk) * 2560);
                float cur[8], a[8];
#pragma unroll
                for (int j = 0; j < 4; ++j) { cur[2 * j] = bf_lo(rw[j]); cur[2 * j + 1] = bf_hi(rw[j]); }
#pragma unroll
                for (int j = 0; j < 8; ++j) { const float y = bi[j] + w0[j] * p3[j] + w1[j] * p2[j] + w2[j] * p1[j] + w3[j] * cur[j]; a[j] = silu(y); p3[j] = p2[j]; p2[j] = p1[j]; p1[j] = cur[j]; }
                if (cs >= 3) { u32x4 o; o.x = pk_bf16(a[0], a[1]); o.y = pk_bf16(a[2], a[3]); o.z = pk_bf16(a[4], a[5]); o.w = pk_bf16(a[6], a[7]); *(u32x4*)(dstR + (size_t)(t8 * 8 + tk) * 1024) = o; }
                if (tk & 1) {
#pragma unroll
                    for (int j = 0; j < 8; ++j) tr[j][tk >> 1] = pk_bf16(ev[j], a[j]);
                } else {
#pragma unroll
                    for (int j = 0; j < 8; ++j) ev[j] = a[j];
                }
            }
            if (cs <= 3) {
#pragma unroll
                for (int j = 0; j < 8; ++j) { u32x4 o; o.x = tr[j][0]; o.y = tr[j][1]; o.z = tr[j][2]; o.w = tr[j][3]; *(u32x4*)(dstT + (size_t)j * SEQ + t8 * 8) = o; }
            }
        }
    }
}

constexpr int L_C = 0, L_B = 34816, L_BT = 69632, L_XT = 104448, L_XW = 121856, L_S = 139264, L_DT = 156672, L_ACS = L_DT + 512, L_W = L_ACS + 512;
__device__ __forceinline__ void ssd_item(const Params& P, LAS unsigned char* lds, int item) {
    int tid_ = threadIdx.x; asm volatile("" : "+v"(tid_)); const int tid = tid_, lane = tid & 63, wid = __builtin_amdgcn_readfirstlane(tid >> 6), r = lane & 15, q = lane >> 4;
    const int b = item / NH, h = item % NH, g = h / 6;
    const bf16_t* BC = (const bf16_t*)(P.ws + WS_BC); const bf16_t* BT = (const bf16_t*)(P.ws + WS_BT); const bf16_t* XT = (const bf16_t*)P.out;
    const bf16_t* uz = (const bf16_t*)(P.ws + WS_UZ); bf16_t* mixed = (bf16_t*)(P.ws + WS_XBC); float* ssq = (float*)(P.ws + WS_SSQ);
    const float* dtr = (const float*)(P.ws + WS_DT) + (size_t)(b * NH + h) * SEQ;
    const float dtb = P.in[6][h], a_neg = -__expf(P.in[7][h]), Dh = P.in[8][h];
    LAS bf16_t* sC = (LAS bf16_t*)(lds + L_C); LAS bf16_t* sB = (LAS bf16_t*)(lds + L_B); LAS bf16_t* sBT = (LAS bf16_t*)(lds + L_BT);
    LAS bf16_t* sXT = (LAS bf16_t*)(lds + L_XT); LAS bf16_t* sXW = (LAS bf16_t*)(lds + L_XW); LAS bf16_t* sS = (LAS bf16_t*)(lds + L_S);
    LAS float* sDt = (LAS float*)(lds + L_DT); LAS float* sAcs = (LAS float*)(lds + L_ACS); LAS float* sWl = (LAS float*)(lds + L_W);
    LAS bf16_t* sM = sB;
    const int nb = wid >> 1, pb = wid & 1;
    f32x4 S[2][2];
#pragma unroll
    for (int i = 0; i < 2; ++i)
#pragma unroll
        for (int j = 0; j < 2; ++j) S[i][j] = (f32x4){0.f, 0.f, 0.f, 0.f};
    for (int c = 0; c < 16; ++c) {
        const size_t tok0 = (size_t)b * SEQ + c * 128;
        u32x4 gC[4], gB[4], gBT[4], gX[2];
#pragma unroll
        for (int i = 0; i < 4; ++i) { const int id = tid + NTHREADS * i, row = id >> 4, c8 = (id & 15) * 8;
            gC[i] = *(const u32x4*)(BC + (tok0 + row) * 1024 + 512 + g * 128 + c8);
            gB[i] = *(const u32x4*)(BC + (tok0 + row) * 1024 + g * 128 + c8);
            gBT[i] = *(const u32x4*)(BT + ((size_t)b * 512 + g * 128 + row) * SEQ + c * 128 + c8); }
#pragma unroll
        for (int i = 0; i < 2; ++i) { const int id = tid + NTHREADS * i, row = id >> 4, c8 = (id & 15) * 8;
            gX[i] = *(const u32x4*)(XT + ((size_t)b * 1536 + h * 64 + row) * SEQ + c * 128 + c8); }
        if (wid == 0) {
            const f32x2 d = *(const f32x2*)(dtr + c * 128 + 2 * lane);
            const float dt0 = softplus(d.x + dtb), dt1 = softplus(d.y + dtb);
            const float a0 = dt0 * a_neg, a1 = dt1 * a_neg;
            float s = a0 + a1;
#pragma unroll
            for (int o = 1; o < 64; o <<= 1) { const float t = __shfl_up(s, o); if (lane >= o) s += t; }
            const float acs1 = s, acs0 = s - a1, aend = __shfl(s, 63);
            sDt[2 * lane] = dt0; sDt[2 * lane + 1] = dt1; sAcs[2 * lane] = acs0; sAcs[2 * lane + 1] = acs1;
            sWl[2 * lane] = dt0 * __expf(aend - acs0); sWl[2 * lane + 1] = dt1 * __expf(aend - acs1);
        }
#pragma unroll
        for (int i = 0; i < 2; ++i)
#pragma unroll
            for (int j = 0; j < 2; ++j) { u32x2 o; o.x = pk_bf16(S[i][j][0], S[i][j][1]); o.y = pk_bf16(S[i][j][2], S[i][j][3]);
                *(LAS u32x2*)(sS + (32 * pb + 16 * j + r) * PT + 32 * nb + 16 * i + 4 * q) = o; }
        __syncthreads();
#pragma unroll
        for (int i = 0; i < 4; ++i) { const int id = tid + NTHREADS * i, row = id >> 4, c8 = (id & 15) * 8;
            *(LAS u32x4*)(sC + row * PT + c8) = gC[i]; *(LAS u32x4*)(sB + row * PT + c8) = gB[i]; *(LAS u32x4*)(sBT + row * PT + c8) = gBT[i]; }
#pragma unroll
        for (int i = 0; i < 2; ++i) { const int id = tid + NTHREADS * i, row = id >> 4, c8 = (id & 15) * 8;
            *(LAS u32x4*)(sXT + row * PT + c8) = gX[i];
            const f32x4 wa = *(const LAS f32x4*)(sWl + c8), wb = *(const LAS f32x4*)(sWl + c8 + 4);
            u32x4 o; o.x = pk_bf16(bf_lo(gX[i].x) * wa[0], bf_hi(gX[i].x) * wa[1]); o.y = pk_bf16(bf_lo(gX[i].y) * wa[2], bf_hi(gX[i].y) * wa[3]);
            o.z = pk_bf16(bf_lo(gX[i].z) * wb[0], bf_hi(gX[i].z) * wb[1]); o.w = pk_bf16(bf_lo(gX[i].w) * wb[2], bf_hi(gX[i].w) * wb[3]);
            *(LAS u32x4*)(sXW + row * PT + c8) = o; }
        __syncthreads();
        f32x4 cb[8];
#pragma unroll
        for (int sb = 0; sb < 8; ++sb) cb[sb] = (f32x4){0.f, 0.f, 0.f, 0.f};
#pragma unroll
        for (int ks = 0; ks < 4; ++ks) {
            const bf16x8 cf = ldfrag(sC, 16 * wid + r, 32 * ks + 8 * q);
#pragma unroll
            for (int sb = 0; sb < 8; ++sb) if (sb <= wid) { const bf16x8 bfr = ldfrag(sB, 16 * sb + r, 32 * ks + 8 * q); cb[sb] = mfma16(bfr, cf, cb[sb]); }
        }
        __syncthreads();
        const int lrow = 16 * wid + r;
        const float acs_l = sAcs[lrow];
#pragma unroll
        for (int sb = 0; sb < 8; ++sb) if (sb <= (wid | 1)) {
            u32x2 o; o.x = 0u; o.y = 0u;
            if (sb <= wid) {
                const f32x4 as = *(const LAS f32x4*)(sAcs + 16 * sb + 4 * q), ds = *(const LAS f32x4*)(sDt + 16 * sb + 4 * q);
                float m[4];
#pragma unroll
                for (int e = 0; e < 4; ++e) { const int s = 16 * sb + 4 * q + e;
                    float v = cb[sb][e] * __expf(acs_l - as[e]) * ds[e];
                    v = (s <= lrow) ? v : 0.f; if (s == lrow) v += Dh; m[e] = v; }
                o.x = pk_bf16(m[0], m[1]); o.y = pk_bf16(m[2], m[3]);
            }
            *(LAS u32x2*)(sM + lrow * PT + 16 * sb + 4 * q) = o;
        }
        __syncthreads();
        f32x4 y[4];
#pragma unroll
        for (int pt = 0; pt < 4; ++pt) y[pt] = (f32x4){0.f, 0.f, 0.f, 0.f};
#pragma unroll
        for (int ks = 0; ks < 4; ++ks) {
            const bf16x8 cf = ldfrag(sC, lrow, 32 * ks + 8 * q);
#pragma unroll
            for (int pt = 0; pt < 4; ++pt) { const bf16x8 sf = ldfrag(sS, 16 * pt + r, 32 * ks + 8 * q); y[pt] = mfma16(sf, cf, y[pt]); }
        }
        { const float el = __expf(acs_l);
#pragma unroll
          for (int pt = 0; pt < 4; ++pt) y[pt] *= el; }
#pragma unroll
        for (int ks = 0; ks < 4; ++ks) if (ks <= (wid >> 1)) {
            const bf16x8 mf = ldfrag(sM, lrow, 32 * ks + 8 * q);
#pragma unroll
            for (int pt = 0; pt < 4; ++pt) { const bf16x8 xf = ldfrag(sXT, 16 * pt + r, 32 * ks + 8 * q); y[pt] = mfma16(xf, mf, y[pt]); }
        }
        { const size_t tok = tok0 + lrow; float ss = 0.f;
#pragma unroll
          for (int pt = 0; pt < 4; ++pt) {
              const u32x2 zz = *(const u32x2*)(uz + tok * 2048 + 512 + h * 64 + 16 * pt + 4 * q);
              const float v0 = y[pt][0] * silu(bf_lo(zz.x)), v1 = y[pt][1] * silu(bf_hi(zz.x)), v2 = y[pt][2] * silu(bf_lo(zz.y)), v3 = y[pt][3] * silu(bf_hi(zz.y));
              ss += v0 * v0 + v1 * v1 + v2 * v2 + v3 * v3;
              u32x2 o; o.x = pk_bf16(v0, v1); o.y = pk_bf16(v2, v3);
              *(u32x2*)(mixed + tok * 2048 + 512 + h * 64 + 16 * pt + 4 * q) = o; }
          ss += __shfl_xor(ss, 16); ss += __shfl_xor(ss, 32);
          if (q == 0) ssq[tok * NH + h] = ss; }
        { const float cd = __expf(sAcs[127]);
#pragma unroll
          for (int i = 0; i < 2; ++i)
#pragma unroll
              for (int j = 0; j < 2; ++j) S[i][j] *= cd; }
#pragma unroll
        for (int ks = 0; ks < 4; ++ks) {
            bf16x8 af[2], bfr[2];
#pragma unroll
            for (int i = 0; i < 2; ++i) { af[i] = ldfrag(sBT, 32 * nb + 16 * i + r, 32 * ks + 8 * q); bfr[i] = ldfrag(sXW, 32 * pb + 16 * i + r, 32 * ks + 8 * q); }
#pragma unroll
            for (int i = 0; i < 2; ++i)
#pragma unroll
                for (int j = 0; j < 2; ++j) S[i][j] = mfma16(af[i], bfr[j], S[i][j]);
        }
        __syncthreads();
    }
}

constexpr int LP_U = 0, LP_D = 144 * PT * 2  , LP_W = LP_D + 128 * PT * 2  ;
__device__ __forceinline__ void pool_item(const Params& P, LAS unsigned char* lds, int item) {
    int tid_ = threadIdx.x; asm volatile("" : "+v"(tid_)); const int tid = tid_, lane = tid & 63, wid = __builtin_amdgcn_readfirstlane(tid >> 6), r = lane & 15, q = lane >> 4;
    const int g = item & 3, tile = item >> 2, t0 = tile * 128, pos0 = t0 & 2047, win = 2 << g;
    const bf16_t* uz = (const bf16_t*)(P.ws + WS_UZ); bf16_t* mixed = (bf16_t*)(P.ws + WS_XBC);
    const bf16_t* wp = (const bf16_t*)(P.ws + WS_WPOOL) + (size_t)g * 16384;
    const float* pscale = P.in[3];
    LAS bf16_t* sU = (LAS bf16_t*)(lds + LP_U); LAS bf16_t* sD = (LAS bf16_t*)(lds + LP_D); LAS bf16_t* sW = (LAS bf16_t*)(lds + LP_W);
    for (int id = tid; id < 144 * 16; id += NTHREADS) { const int row = id >> 4, c8 = (id & 15) * 8;
        u32x4 v; v.x = 0u; v.y = 0u; v.z = 0u; v.w = 0u;
        if (row >= 16 || pos0 != 0) v = *(const u32x4*)(uz + ((size_t)t0 + row - 16) * 2048 + g * 128 + c8);
        *(LAS u32x4*)(sU + row * PT + c8) = v; }
#pragma unroll
    for (int i = 0; i < 4; ++i) { const int id = tid + NTHREADS * i, row = id >> 4, c8 = (id & 15) * 8; *(LAS u32x4*)(sW + row * PT + c8) = *(const u32x4*)(wp + row * 128 + c8); }
    __syncthreads();
    { const int cp = tid & 63, seg = tid >> 6;
      float s0 = 0.f, s1 = 0.f;
      for (int k = 1; k < win; ++k) { const unsigned v = *(const LAS unsigned*)(sU + (16 * seg + 16 - k) * PT + 2 * cp); s0 += bf_lo(v); s1 += bf_hi(v); }
      for (int t = 0; t < 16; ++t) { const int tl = 16 * seg + t;
          const unsigned v = *(const LAS unsigned*)(sU + (tl + 16) * PT + 2 * cp); const float u0 = bf_lo(v), u1 = bf_hi(v);
          s0 += u0; s1 += u1;
          const int pos = pos0 + tl; const float inv = 1.0f / (float)((pos + 1) < win ? (pos + 1) : win);
          *(LAS unsigned*)(sD + tl * PT + 2 * cp) = pk_bf16(s0 * inv - u0, s1 * inv - u1);
          const unsigned o = *(const LAS unsigned*)(sU + (tl + 17 - win) * PT + 2 * cp); s0 -= bf_lo(o); s1 -= bf_hi(o); } }
    __syncthreads();
    f32x4 acc[8];
#pragma unroll
    for (int db = 0; db < 8; ++db) acc[db] = (f32x4){0.f, 0.f, 0.f, 0.f};
#pragma unroll
    for (int ks = 0; ks < 4; ++ks) { const bf16x8 df = ldfrag(sD, 16 * wid + r, 32 * ks + 8 * q);
#pragma unroll
        for (int db = 0; db < 8; ++db) { const bf16x8 wf = ldfrag(sW, 16 * db + r, 32 * ks + 8 * q); acc[db] = mfma16(wf, df, acc[db]); } }
    { const size_t tok = (size_t)t0 + 16 * wid + r;
#pragma unroll
      for (int db = 0; db < 8; ++db) { const f32x4 sc = *(const f32x4*)(pscale + g * 128 + 16 * db + 4 * q);
          u32x2 o; o.x = pk_bf16(acc[db][0] * sc[0], acc[db][1] * sc[1]); o.y = pk_bf16(acc[db][2] * sc[2], acc[db][3] * sc[3]);
          *(u32x2*)(mixed + tok * 2048 + g * 128 + 16 * db + 4 * q) = o; } }
    __syncthreads();
}

__device__ __forceinline__ void phase_mix(const Params& P, LAS unsigned char* lds) {
    const int G = gridDim.x, bid = blockIdx.x;
    for (int it = bid; it < 16 * NH; it += G) ssd_item(P, lds, it);
    const int lo = (16 * NH) % G, np = G - lo;
    if (bid >= lo) for (int pi = bid - lo; pi < 1024; pi += np) pool_item(P, lds, pi);
}

__device__ __forceinline__ void phase_rms(const Params& P) {
    int tid_ = threadIdx.x; asm volatile("" : "+v"(tid_)); const int tid = tid_, lane = tid & 63, wid = tid >> 6, nW = gridDim.x * 8;
    bf16_t* mixed = (bf16_t*)(P.ws + WS_XBC); const float* ssq = (const float*)(P.ws + WS_SSQ); const float* nw = P.in[9];
    for (int tok = blockIdx.x * 8 + wid; tok < MTOK; tok += nW) {
        bf16_t* p = mixed + (size_t)tok * 2048 + 512; const float* sq = ssq + (size_t)tok * NH;
#pragma unroll
        for (int i = 0; i < 3; ++i) { const int ci = lane + 64 * i, grp = ci / 48;
            const float s = (sq[grp * 6] + sq[grp * 6 + 1]) + (sq[grp * 6 + 2] + sq[grp * 6 + 3]) + (sq[grp * 6 + 4] + sq[grp * 6 + 5]);
            const float sc = 1.0f / sqrtf(s * (1.0f / 384.0f) + RMS_EPS);
            const u32x4 v = *(const u32x4*)(p + ci * 8); const f32x4 wa = *(const f32x4*)(nw + ci * 8), wb = *(const f32x4*)(nw + ci * 8 + 4);
            u32x4 o; o.x = pk_bf16(bf_lo(v.x) * sc * wa[0], bf_hi(v.x) * sc * wa[1]); o.y = pk_bf16(bf_lo(v.y) * sc * wa[2], bf_hi(v.y) * sc * wa[3]);
            o.z = pk_bf16(bf_lo(v.z) * sc * wb[0], bf_hi(v.z) * sc * wb[1]); o.w = pk_bf16(bf_lo(v.w) * sc * wb[2], bf_hi(v.w) * sc * wb[3]);
            *(u32x4*)(p + ci * 8) = o; }
    }
}

__device__ __forceinline__ void phase_ln(const float* gam, const float* bet, float* io, bf16_t* ob) {
    int tid_ = threadIdx.x; asm volatile("" : "+v"(tid_)); const int tid = tid_, lane = tid & 63, wid = tid >> 6, nW = gridDim.x * 8;
    f32x4 gg[4], bb[4];
#pragma unroll
    for (int j = 0; j < 4; ++j) { gg[j] = *(const f32x4*)(gam + 4 * lane + 256 * j); bb[j] = *(const f32x4*)(bet + 4 * lane + 256 * j); }
    for (int row = blockIdx.x * 8 + wid; row < MTOK; row += nW) {
        float* p = io + (size_t)row * DM + 4 * lane;
        f32x4 v[4]; float s = 0.f;
#pragma unroll
        for (int j = 0; j < 4; ++j) { v[j] = *(const f32x4*)(p + 256 * j); s += (v[j][0] + v[j][1]) + (v[j][2] + v[j][3]); }
#pragma unroll
        for (int o = 1; o < 64; o <<= 1) s += __shfl_xor(s, o);
        const float mean = s * (1.0f / 1024.0f); float qq = 0.f;
#pragma unroll
        for (int j = 0; j < 4; ++j) { v[j] = v[j] - mean; qq += (v[j][0] * v[j][0] + v[j][1] * v[j][1]) + (v[j][2] * v[j][2] + v[j][3] * v[j][3]); }
#pragma unroll
        for (int o = 1; o < 64; o <<= 1) qq += __shfl_xor(qq, o);
        const float rstd = 1.0f / sqrtf(qq * (1.0f / 1024.0f) + LN_EPS);
#pragma unroll
        for (int j = 0; j < 4; ++j) { const f32x4 o = v[j] * rstd * gg[j] + bb[j]; *(f32x4*)(p + 256 * j) = o;
            if (ob) { u32x2 w; w.x = pk_bf16(o[0], o[1]); w.y = pk_bf16(o[2], o[3]); *(u32x2*)(ob + (size_t)row * DM + 4 * lane + 256 * j) = w; } }
    }
}

struct EpiProj {
    static constexpr bool PERM = true, AFTER_DRAIN = false;
    bf16_t* uz; bf16_t* xbc;
    __device__ __forceinline__ void operator()(const pg8::f32x4 (&acc)[2][2][4][2], const pg8::Unit& u, int wr, int wc, int fr, int fq) const {
        const int row0 = u.pm * 256 + wr * 64 + fr; int colt = u.pn * 256; bf16_t* base = uz; int ldc = 2048;
        if (colt >= 2048) { base = xbc; ldc = 2560; colt -= 2048; }
        const int col0 = colt + wc * 32 + 8 * fq;
#pragma unroll
        for (int ai = 0; ai < 2; ++ai)
#pragma unroll
            for (int m = 0; m < 4; ++m) { bf16_t* rowp = base + (size_t)(row0 + ai * 128 + m * 16) * ldc + col0;
#pragma unroll
                for (int bj = 0; bj < 2; ++bj) { const pg8::f32x4 v0 = acc[ai][bj][m][0], v1 = acc[ai][bj][m][1];
                    u32x4 w; w.x = pk_bf16(v0[0], v0[1]); w.y = pk_bf16(v0[2], v0[3]); w.z = pk_bf16(v1[0], v1[1]); w.w = pk_bf16(v1[2], v1[3]);
                    *(u32x4*)(rowp + bj * 128) = w; } }
    }
};
struct EpiRelu2 {
    static constexpr bool PERM = true, AFTER_DRAIN = false;
    bf16_t* o;
    __device__ __forceinline__ void operator()(const pg8::f32x4 (&acc)[2][2][4][2], const pg8::Unit& u, int wr, int wc, int fr, int fq) const {
        const int row0 = u.pm * 256 + wr * 64 + fr, col0 = u.pn * 256 + wc * 32 + 8 * fq;
#pragma unroll
        for (int ai = 0; ai < 2; ++ai)
#pragma unroll
            for (int m = 0; m < 4; ++m) { bf16_t* rowp = o + (size_t)(row0 + ai * 128 + m * 16) * DFF + col0;
#pragma unroll
                for (int bj = 0; bj < 2; ++bj) { pg8::f32x4 v0 = acc[ai][bj][m][0], v1 = acc[ai][bj][m][1];
#pragma unroll
                    for (int e = 0; e < 4; ++e) { const float a = fmaxf(v0[e], 0.f), c = fmaxf(v1[e], 0.f); v0[e] = a * a; v1[e] = c * c; }
                    u32x4 w; w.x = pk_bf16(v0[0], v0[1]); w.y = pk_bf16(v0[2], v0[3]); w.z = pk_bf16(v1[0], v1[1]); w.w = pk_bf16(v1[2], v1[3]);
                    *(u32x4*)(rowp + bj * 128) = w; } }
    }
};
struct EpiResid {
    static constexpr bool PERM = false, AFTER_DRAIN = false;
    const float* base; float* out;
    __device__ __forceinline__ void operator()(const pg8::f32x4 (&acc)[2][2][4][2], const pg8::Unit& u, int wr, int wc, int fr, int fq) const {
        const int row0 = u.pm * 256 + wr * 64 + fr, col0 = u.pn * 256 + wc * 32 + 4 * fq;
#pragma unroll
        for (int ai = 0; ai < 2; ++ai)
#pragma unroll
            for (int m = 0; m < 4; ++m) { const size_t off = (size_t)(row0 + ai * 128 + m * 16) * DM + col0;
#pragma unroll
                for (int bj = 0; bj < 2; ++bj)
#pragma unroll
                    for (int n = 0; n < 2; ++n) { const pg8::f32x4 bs = *(const pg8::f32x4*)(base + off + bj * 128 + n * 16);
                        *(pg8::f32x4*)(out + off + bj * 128 + n * 16) = bs * ALPHA + acc[ai][bj][m][n]; } }
    }
};

__global__ void __launch_bounds__(NTHREADS, 2) mega(Params P) {
    extern __shared__ __attribute__((aligned(16))) unsigned char lds_raw[];
    LAS unsigned char* lds = (LAS unsigned char*)lds_raw;
    cg::grid_group grid = cg::this_grid();
    unsigned char* ws = P.ws;
    const int lo = P.ph_lo, hi = P.ph_hi;
#define IN(k) (lo <= (k) && (k) < hi)
#define SEAM(k) do { if (IN(k) && IN((k) + 1)) grid.sync(); } while (0)
    if (IN(0)) phase0(P, lds);
    SEAM(0);
    if (IN(1)) { pg8::Gemm g{(const pg8::bf16_t*)P.out, (const pg8::bf16_t*)(ws + WS_WIN), MTOK, NPROJ, DM}; pg8::StaticOrder S; S.init(MTOK, NPROJ, (int)gridDim.x, (int)blockIdx.x);
        EpiProj E{(bf16_t*)(ws + WS_UZ), (bf16_t*)(ws + WS_XBC)}; pg8::gemm_phase<EpiProj, pg8::StaticOrder>(lds, g, S, E, nullptr); }
    SEAM(1);
    if (IN(2)) phase_conv(P);
    SEAM(2);
    if (IN(3)) phase_mix(P, lds);
    SEAM(3);
    if (IN(4)) phase_rms(P);
    SEAM(4);
    if (IN(5)) { pg8::Gemm g{(const pg8::bf16_t*)(ws + WS_XBC), (const pg8::bf16_t*)(ws + WS_WOUT), MTOK, DM, DMIX}; pg8::StaticOrder S; S.init(MTOK, DM, (int)gridDim.x, (int)blockIdx.x);
        EpiResid E{P.in[0], P.out}; pg8::gemm_phase<EpiResid, pg8::StaticOrder>(lds, g, S, E, nullptr); }
    SEAM(5);
    if (IN(6)) phase_ln(P.in[11], P.in[12], P.out, (bf16_t*)(ws + WS_HB));
    SEAM(6);
    if (IN(7)) { pg8::Gemm g{(const pg8::bf16_t*)(ws + WS_HB), (const pg8::bf16_t*)(ws + WS_WFF1), MTOK, DFF, DM}; pg8::StaticOrder S; S.init(MTOK, DFF, (int)gridDim.x, (int)blockIdx.x);
        EpiRelu2 E{(bf16_t*)(ws + WS_H1)}; pg8::gemm_phase<EpiRelu2, pg8::StaticOrder>(lds, g, S, E, nullptr); }
    SEAM(7);
    if (IN(8)) { pg8::Gemm g{(const pg8::bf16_t*)(ws + WS_H1), (const pg8::bf16_t*)(ws + WS_WFF2), MTOK, DM, DFF}; pg8::StaticOrder S; S.init(MTOK, DM, (int)gridDim.x, (int)blockIdx.x);
        EpiResid E{P.out, P.out}; pg8::gemm_phase<EpiResid, pg8::StaticOrder>(lds, g, S, E, nullptr); }
    SEAM(8);
    if (IN(9)) phase_ln(P.in[15], P.in[16], P.out, nullptr);
#undef IN
#undef SEAM
}
}

#ifndef MK_N_LAUNCHES
#define MK_N_LAUNCHES 1
#endif
extern "C" void kernel_launch(void* const* d_in, const int* in_sizes, int n_in, void* d_out, int out_size, void* d_ws, size_t ws_size, hipStream_t stream) {
    static int grid = 0;
    if (grid == 0) {
        if (n_in != 17 || out_size != mk::MTOK * mk::DM || ws_size < mk::WS_END) { fprintf(stderr, "kernel_launch: unexpected shapes (n_in %d out %d ws %zu)\n", n_in, out_size, ws_size); grid = -1; return; }
        int dev = 0, cus = 0, per_cu = 0;
        hipGetDevice(&dev); hipDeviceGetAttribute(&cus, hipDeviceAttributeMultiprocessorCount, dev);
        if (hipFuncSetAttribute((const void*)mk::mega, hipFuncAttributeMaxDynamicSharedMemorySize, mk::LDS_BYTES) != hipSuccess) { fprintf(stderr, "kernel_launch: hipFuncSetAttribute failed\n"); }
        if (hipOccupancyMaxActiveBlocksPerMultiprocessor(&per_cu, (const void*)mk::mega, mk::NTHREADS, mk::LDS_BYTES) != hipSuccess || per_cu < 1) { fprintf(stderr, "kernel_launch: occupancy query says %d\n", per_cu); per_cu = 1; }
        (void)hipGetLastError();
        grid = cus * per_cu;
        fprintf(stderr, "kernel_launch: grid %d (%d CUs x %d)\n", grid, cus, per_cu);
    }
    if (grid < 0) return;
    mk::Params p{};
    for (int i = 0; i < 17; ++i) p.in[i] = (const float*)d_in[i];
    p.out = (float*)d_out; p.ws = (unsigned char*)d_ws;
#if MK_N_LAUNCHES == 1
    p.ph_lo = 0; p.ph_hi = 10;
    void* args[] = {&p};
    hipError_t e = hipLaunchCooperativeKernel((const void*)mk::mega, dim3(grid), dim3(mk::NTHREADS), args, mk::LDS_BYTES, stream);
    if (e != hipSuccess) fprintf(stderr, "kernel_launch: cooperative launch failed: %s (grid %d)\n", hipGetErrorString(e), grid);
#else
    for (int ph = 0; ph < 10; ++ph) { p.ph_lo = ph; p.ph_hi = ph + 1; hipLaunchKernelGGL(mk::mega, dim3(grid), dim3(mk::NTHREADS), mk::LDS_BYTES, stream, p); }
#endif
}
```

```cpp
#include <hip/hip_runtime.h>
#include <hip/hip_cooperative_groups.h>
#include <cstdio>
namespace pg8 {
#define PG8_LAS __attribute__((address_space(3)))
typedef unsigned short bf16_t;
typedef short bf16x8 __attribute__((ext_vector_type(8)));
typedef float f32x4 __attribute__((ext_vector_type(4)));
typedef unsigned u32x4 __attribute__((ext_vector_type(4)));
constexpr int BM = 256, BK = 64, HALF = 128, HTB = HALF * BK * 2  , STAGE_BYTES = 8 * HTB, NXCD = 8, WGM = 8;

__host__ __device__ __forceinline__ int lds_byte(int r, int c) { const int st = (r >> 4) * 2 + (c >> 5), rr = r & 15, cc = c & 31, ob = rr * 64 + cc * 2; return st * 1024 + (ob ^ (((ob >> 9) & 1) << 5)); }
__host__ __device__ __forceinline__ void stage_rc(int b, int& R, int& C) { const int st = b / 1024, sb = b % 1024, swz = sb ^ (((sb >> 9) & 1) << 5); R = (st >> 1) * 16 + swz / 64; C = (st & 1) * 32 + (swz % 64) / 2; }
__host__ __device__ __forceinline__ int perm32(int rho) { const int n = rho >> 4, i = rho & 15; return 8 * (i >> 2) + 4 * n + (i & 3); }

struct Unit { int pm, pn; };
struct Gemm { const bf16_t* A; const bf16_t* Bt; int M, N, K; };

struct StaticOrder {
    int nM, nN, nwg, G, c;
    __host__ __device__ void init(int M, int N, int G_, int c_) { nM = M / BM; nN = N / BM; nwg = nM * nN; G = G_; c = c_; }
    __host__ __device__ bool next(int i, Unit& u) const {
        const long L = (long)i * G + c; if (L >= nwg) return false;
        int wgid = (int)L; { const int q = nwg / NXCD, r = nwg % NXCD, xcd = wgid % NXCD, off = wgid / NXCD; wgid = (xcd < r ? xcd * (q + 1) : r * (q + 1) + (xcd - r) * q) + off; }
        const int nig = WGM * nN, gid = wgid / nig, fm = gid * WGM, gsz = (nM - fm) < WGM ? (nM - fm) : WGM;
        u.pm = fm + ((wgid % nig) % gsz); u.pn = (wgid % nig) / gsz; return true;
    }
    __device__ __forceinline__ void a_ready(const Unit&) const {}
    __device__ __forceinline__ void done(const Unit&) const {}
};
struct CountedOrder : StaticOrder {
    const unsigned* ready; unsigned need; unsigned* tmo;
    __device__ __forceinline__ void a_ready(const Unit& u) const {
        if (threadIdx.x < 64) {
            const unsigned long long t0 = __builtin_amdgcn_s_memrealtime(); unsigned polls = 0;
            while ((unsigned)__builtin_amdgcn_readfirstlane(__hip_atomic_load(ready + 64 * u.pm, __ATOMIC_RELAXED, __HIP_MEMORY_SCOPE_AGENT)) < need) {
                if ((++polls & 255u) == 0u && __builtin_amdgcn_readfirstlane(__hip_atomic_load(tmo, __ATOMIC_RELAXED, __HIP_MEMORY_SCOPE_AGENT)) != 0u) break;
                if (__builtin_amdgcn_s_memrealtime() - t0 > 2000000ull) {
                    if (threadIdx.x == 0) { unsigned expect = 0u; __hip_atomic_compare_exchange_strong(tmo + 1, &expect, 0x600u | (unsigned)(u.pm & 0xff), __ATOMIC_RELAXED, __ATOMIC_RELAXED, __HIP_MEMORY_SCOPE_AGENT); __hip_atomic_store(tmo, 1u, __ATOMIC_RELAXED, __HIP_MEMORY_SCOPE_AGENT); }
                    break; }
                __builtin_amdgcn_s_sleep(2); }
            __builtin_amdgcn_fence(__ATOMIC_ACQUIRE, "agent");
            asm volatile("s_waitcnt vmcnt(0)" ::: "memory");
        }
#if !defined(BROKEN_HOOK_NO_BARRIER)
        asm volatile("" ::: "memory"); __builtin_amdgcn_s_barrier(); asm volatile("" ::: "memory");
#endif
    }
};

__device__ __forceinline__ unsigned cvt_pk_bf16(float lo, float hi) { unsigned r; asm volatile("v_cvt_pk_bf16_f32 %0, %1, %2" : "=v"(r) : "v"(lo), "v"(hi)); return r; }
typedef float f32x2 __attribute__((ext_vector_type(2)));
__device__ __forceinline__ f32x2 gelu_pk(f32x2 v) {
    const f32x2 av = __builtin_elementwise_abs(v), d = av * 0.2316418882f + 1.0f;
    f32x2 t; t.x = __builtin_amdgcn_rcpf(d.x); t.y = __builtin_amdgcn_rcpf(d.y);
    f32x2 q = t * 0.5307027145f + (-0.7265760135f); q = q * t + 0.7107068705f; q = q * t + (-0.142248368f); q = q * t + 0.127414796f; q = q * t;
    const f32x2 s = (v * v) * (-0.72134752044f);
    f32x2 e; e.x = __builtin_amdgcn_exp2f(s.x); e.y = __builtin_amdgcn_exp2f(s.y);
    const f32x2 m = v * (q * e), r = v - m;
    f32x2 o; o.x = v.x < 0.f ? m.x : r.x; o.y = v.y < 0.f ? m.y : r.y; return o;
}

struct EpiF32 {
    static constexpr bool PERM = false, AFTER_DRAIN = false;
    float* C; int ldc; const float* bias;
    __device__ __forceinline__ void operator()(const f32x4 (&acc)[2][2][4][2], const Unit& u, int wr, int wc, int fr, int fq) const {
        const int row0 = u.pm * BM + wr * 64 + fr, col0 = u.pn * BM + wc * 32 + 4 * fq;
        f32x4 bv[2][2];
#pragma unroll
        for (int bj = 0; bj < 2; ++bj)
#pragma unroll
            for (int n = 0; n < 2; ++n) bv[bj][n] = bias ? *(const f32x4*)(bias + col0 + bj * HALF + n * 16) : (f32x4){0.f, 0.f, 0.f, 0.f};
#pragma unroll
        for (int ai = 0; ai < 2; ++ai)
#pragma unroll
            for (int m = 0; m < 4; ++m) { float* rowp = C + (size_t)(row0 + ai * HALF + m * 16) * ldc + col0;
#pragma unroll
                for (int bj = 0; bj < 2; ++bj)
#pragma unroll
                    for (int n = 0; n < 2; ++n) *(f32x4*)(rowp + bj * HALF + n * 16) = acc[ai][bj][m][n] + bv[bj][n]; }
    }
};
template <int ACT  > struct EpiBf16 {
    static constexpr bool PERM = true, AFTER_DRAIN = false;
    bf16_t* O; int ldc; const float* bias; int split_cols; size_t split_stride;
    __device__ __forceinline__ void operator()(const f32x4 (&acc)[2][2][4][2], const Unit& u, int wr, int wc, int fr, int fq) const {
        const int row0 = u.pm * BM + wr * 64 + fr; int colt = u.pn * BM; bf16_t* base = O;
        if (split_cols) { const int t = colt / split_cols; base += (size_t)t * split_stride; colt -= t * split_cols; }
        const int col0 = colt + wc * 32 + 8 * fq, bcol0 = u.pn * BM + wc * 32 + 8 * fq;
        f32x4 bv[2][2];
#pragma unroll
        for (int bj = 0; bj < 2; ++bj)
#pragma unroll
            for (int n = 0; n < 2; ++n) bv[bj][n] = bias ? *(const f32x4*)(bias + bcol0 + bj * HALF + 4 * n) : (f32x4){0.f, 0.f, 0.f, 0.f};
#pragma unroll
        for (int ai = 0; ai < 2; ++ai)
#pragma unroll
            for (int m = 0; m < 4; ++m) { bf16_t* rowp = base + (size_t)(row0 + ai * HALF + m * 16) * ldc + col0;
#pragma unroll
                for (int bj = 0; bj < 2; ++bj) { f32x4 v0 = acc[ai][bj][m][0] + bv[bj][0], v1 = acc[ai][bj][m][1] + bv[bj][1];
                    if (ACT == 1) { f32x2 a = gelu_pk((f32x2){v0[0], v0[1]}), b = gelu_pk((f32x2){v0[2], v0[3]}), c = gelu_pk((f32x2){v1[0], v1[1]}), d = gelu_pk((f32x2){v1[2], v1[3]});
                        v0 = (f32x4){a.x, a.y, b.x, b.y}; v1 = (f32x4){c.x, c.y, d.x, d.y}; }
                    if (ACT == 2) {
#pragma unroll
                        for (int j = 0; j < 4; ++j) { v0[j] = 0.5f * v0[j] * (1.0f + erff(v0[j] * 0.70710678f)); v1[j] = 0.5f * v1[j] * (1.0f + erff(v1[j] * 0.70710678f)); } }
                    u32x4 w; w.x = cvt_pk_bf16(v0[0], v0[1]); w.y = cvt_pk_bf16(v0[2], v0[3]); w.z = cvt_pk_bf16(v1[0], v1[1]); w.w = cvt_pk_bf16(v1[2], v1[3]);
                    *(u32x4*)(rowp + bj * HALF) = w; } }
    }
};

struct PanelStats {
    unsigned* xbuf;
    unsigned* cnt;
    unsigned* tmo;
    int ntn; float eps;
    unsigned code;
    __device__ __forceinline__ bool run(const f32x4 (&v)[2][2][4][2], const Unit& u, int wr, int wc, int fr, int fq, PG8_LAS unsigned char* lds, int wid, int lane) const {
        typedef float f32x2v __attribute__((ext_vector_type(2)));
        PG8_LAS f32x2v* P = (PG8_LAS f32x2v*)lds;
        PG8_LAS f32x2v* S = (PG8_LAS f32x2v*)(lds + 8192);
        PG8_LAS unsigned* flag = (PG8_LAS unsigned*)(lds + 8192 + 2048);
#pragma unroll
        for (int ai = 0; ai < 2; ++ai)
#pragma unroll
            for (int m = 0; m < 4; ++m) {
                float s = 0.f;
#pragma unroll
                for (int bj = 0; bj < 2; ++bj)
#pragma unroll
                    for (int n = 0; n < 2; ++n) { const f32x4 x = v[ai][bj][m][n]; s += (x[0] + x[1]) + (x[2] + x[3]); }
                s += __shfl_xor(s, 16); s += __shfl_xor(s, 32);
                const float mw = s * (1.0f / 64.0f); float q = 0.f;
#pragma unroll
                for (int bj = 0; bj < 2; ++bj)
#pragma unroll
                    for (int n = 0; n < 2; ++n) { const f32x4 d = v[ai][bj][m][n] - mw; q += (d[0] * d[0] + d[1] * d[1]) + (d[2] * d[2] + d[3] * d[3]); }
                q += __shfl_xor(q, 16); q += __shfl_xor(q, 32);
                if (fq == 0) P[(ai * HALF + wr * 64 + m * 16 + fr) * 4 + wc] = (f32x2v){mw, q};
            }
        asm volatile("s_waitcnt lgkmcnt(0)" ::: "memory"); __builtin_amdgcn_s_barrier(); asm volatile("" ::: "memory");
#if defined(BROKEN_NO_WAIT)
        if (blockIdx.x >= 64) { const long long t0 = clock64(); while (clock64() - t0 < 60000) __builtin_amdgcn_s_sleep(8); }
#endif
        const int row = wid * 32 + (lane & 31);
        if (lane < 32) {
            const f32x2v a = P[row * 4 + 0], b = P[row * 4 + 1], c = P[row * 4 + 2], d = P[row * 4 + 3];
            const float mt = (a.x + b.x + c.x + d.x) * 0.25f;
            const float da = a.x - mt, db = b.x - mt, dc = c.x - mt, dd = d.x - mt;
            const float m2 = (a.y + b.y) + (c.y + d.y) + 64.0f * ((da * da + db * db) + (dc * dc + dd * dd));
            unsigned long long* slot = (unsigned long long*)xbuf + ((size_t)(u.pm * BM + row) * 4 + u.pn);
            __hip_atomic_store(slot, ((unsigned long long)__float_as_uint(m2) << 32) | __float_as_uint(mt), __ATOMIC_RELAXED, __HIP_MEMORY_SCOPE_AGENT);
        }
        asm volatile("s_waitcnt vmcnt(0)" ::: "memory");
        if (lane == 0) __hip_atomic_fetch_add(cnt + 64 * u.pm, 1u, __ATOMIC_RELAXED, __HIP_MEMORY_SCOPE_AGENT);
        if (wid == 0) {
            bool dead = false; const unsigned long long t0 = __builtin_amdgcn_s_memrealtime(); const unsigned want = 8u * (unsigned)ntn;
            for (;;) {
#if defined(BROKEN_NO_WAIT)
                break;
#endif
                if ((unsigned)__builtin_amdgcn_readfirstlane(__hip_atomic_load(cnt + 64 * u.pm, __ATOMIC_RELAXED, __HIP_MEMORY_SCOPE_AGENT)) >= want) break;
                if (__builtin_amdgcn_s_memrealtime() - t0 > 2000000ull) {
                    if (lane == 0) { unsigned expect = 0u; __hip_atomic_compare_exchange_strong(tmo + 1, &expect, code | (unsigned)(u.pm & 0xff), __ATOMIC_RELAXED, __ATOMIC_RELAXED, __HIP_MEMORY_SCOPE_AGENT);
                                     __hip_atomic_store(tmo, 1u, __ATOMIC_RELAXED, __HIP_MEMORY_SCOPE_AGENT); }
                    dead = true; break; }
                __builtin_amdgcn_s_sleep(2);
            }
            __builtin_amdgcn_fence(__ATOMIC_ACQUIRE, "agent");
            if (lane == 0) flag[0] = dead ? 1u : 0u;
        }
        asm volatile("s_waitcnt vmcnt(0) lgkmcnt(0)" ::: "memory"); __builtin_amdgcn_s_barrier(); asm volatile("" ::: "memory");
        const bool bad = flag[0] != 0u;
        if (lane < 32) {
            const unsigned long long* slot = (const unsigned long long*)xbuf + (size_t)(u.pm * BM + row) * 4; float mt[4], m2[4]; float ms = 0.f;
#pragma unroll
            for (int t = 0; t < 4; ++t) { if (t < ntn) { const unsigned long long w = __hip_atomic_load(slot + t, __ATOMIC_RELAXED, __HIP_MEMORY_SCOPE_AGENT); mt[t] = __uint_as_float((unsigned)w); m2[t] = __uint_as_float((unsigned)(w >> 32)); } else { mt[t] = 0.f; m2[t] = 0.f; } ms += mt[t]; }
            const float mean = ms / (float)ntn; float q = 0.f;
#pragma unroll
            for (int t = 0; t < 4; ++t) if (t < ntn) { const float dm = mt[t] - mean; q += m2[t] + 256.0f * dm * dm; }
            S[row] = (f32x2v){mean, 1.0f / sqrtf(q / (256.0f * (float)ntn) + eps)};
        }
        asm volatile("s_waitcnt lgkmcnt(0)" ::: "memory"); __builtin_amdgcn_s_barrier(); asm volatile("" ::: "memory");
        return bad;
    }
};
struct EpiLnRes {
    static constexpr bool PERM = false, AFTER_DRAIN = true;
    const float* base; float* out; int ldc; const float* bias; PanelStats st; unsigned poison;
    __device__ __forceinline__ void refuse(size_t i0, size_t stride, int M, int N) const { const float q = __builtin_nanf(""); for (size_t i = i0; i < (size_t)M * N; i += stride) out[(i / N) * ldc + i % N] = q;
        if (i0 == 0) { unsigned expect = 0u; __hip_atomic_compare_exchange_strong(st.tmo + 1, &expect, 0x7f0u, __ATOMIC_RELAXED, __ATOMIC_RELAXED, __HIP_MEMORY_SCOPE_AGENT); __hip_atomic_store(st.tmo, 1u, __ATOMIC_RELAXED, __HIP_MEMORY_SCOPE_AGENT); } }
    __device__ __forceinline__ void fused(f32x4 (&acc)[2][2][4][2], const Unit& u, int wr, int wc, int fr, int fq, PG8_LAS unsigned char* lds, int wid, int lane) const {
        typedef float f32x2v __attribute__((ext_vector_type(2)));
        const PG8_LAS f32x2v* S = (const PG8_LAS f32x2v*)(lds + 8192);
        const int col0 = u.pn * BM + wc * 32 + 4 * fq;
#pragma unroll
        for (int bj = 0; bj < 2; ++bj)
#pragma unroll
            for (int n = 0; n < 2; ++n) { const f32x4 bv = bias ? *(const f32x4*)(bias + col0 + bj * HALF + n * 16) : (f32x4){0.f, 0.f, 0.f, 0.f};
#pragma unroll
                for (int ai = 0; ai < 2; ++ai)
#pragma unroll
                    for (int m = 0; m < 4; ++m) acc[ai][bj][m][n] += bv; }
        const bool bad = st.run(acc, u, wr, wc, fr, fq, lds, wid, lane) || poison != 0u;
        const float qnan = __builtin_nanf("");
#pragma unroll
        for (int ai = 0; ai < 2; ++ai)
#pragma unroll
            for (int m = 0; m < 4; ++m) { const int r = ai * HALF + wr * 64 + m * 16 + fr; const f32x2v sr = S[r]; const size_t off = (size_t)(u.pm * BM + r) * ldc + col0;
#pragma unroll
                for (int bj = 0; bj < 2; ++bj)
#pragma unroll
                    for (int n = 0; n < 2; ++n) { const f32x4 bs = *(const f32x4*)(base + off + bj * HALF + n * 16); f32x4 o = bs + (acc[ai][bj][m][n] - sr.x) * sr.y;
                        if (bad) o = (f32x4){qnan, qnan, qnan, qnan}; *(f32x4*)(out + off + bj * HALF + n * 16) = o; }
                asm volatile("" ::: "memory"); }
    }
};
struct EpiLnResLn {
    static constexpr bool PERM = false, AFTER_DRAIN = true;
    const float* base; float* out; bf16_t* xn; int ldc; const float* bias; PanelStats st1, st2; unsigned poison;
    __device__ __forceinline__ void refuse(size_t i0, size_t stride, int M, int N) const { const float q = __builtin_nanf(""); for (size_t i = i0; i < (size_t)M * N; i += stride) { const size_t o = (i / N) * ldc + i % N; out[o] = q; xn[o] = (bf16_t)0x7fc0u; }
        if (i0 == 0) { unsigned expect = 0u; __hip_atomic_compare_exchange_strong(st1.tmo + 1, &expect, 0x7f0u, __ATOMIC_RELAXED, __ATOMIC_RELAXED, __HIP_MEMORY_SCOPE_AGENT); __hip_atomic_store(st1.tmo, 1u, __ATOMIC_RELAXED, __HIP_MEMORY_SCOPE_AGENT); } }
    __device__ __forceinline__ void fused(f32x4 (&acc)[2][2][4][2], const Unit& u, int wr, int wc, int fr, int fq, PG8_LAS unsigned char* lds, int wid, int lane) const {
        typedef float f32x2v __attribute__((ext_vector_type(2))); typedef unsigned u32x2v __attribute__((ext_vector_type(2)));
        const PG8_LAS f32x2v* S = (const PG8_LAS f32x2v*)(lds + 8192);
        const int col0 = u.pn * BM + wc * 32 + 4 * fq;
#pragma unroll
        for (int bj = 0; bj < 2; ++bj)
#pragma unroll
            for (int n = 0; n < 2; ++n) { const f32x4 bv = bias ? *(const f32x4*)(bias + col0 + bj * HALF + n * 16) : (f32x4){0.f, 0.f, 0.f, 0.f};
#pragma unroll
                for (int ai = 0; ai < 2; ++ai)
#pragma unroll
                    for (int m = 0; m < 4; ++m) acc[ai][bj][m][n] += bv; }
        bool bad = st1.run(acc, u, wr, wc, fr, fq, lds, wid, lane) || poison != 0u;
        const float qnan = __builtin_nanf("");
#pragma unroll
        for (int ai = 0; ai < 2; ++ai)
#pragma unroll
            for (int m = 0; m < 4; ++m) { const int r = ai * HALF + wr * 64 + m * 16 + fr; const f32x2v sr = S[r]; const size_t off = (size_t)(u.pm * BM + r) * ldc + col0;
#pragma unroll
                for (int bj = 0; bj < 2; ++bj)
#pragma unroll
                    for (int n = 0; n < 2; ++n) { const f32x4 bs = *(const f32x4*)(base + off + bj * HALF + n * 16); acc[ai][bj][m][n] = bs + (acc[ai][bj][m][n] - sr.x) * sr.y; }
                asm volatile("" : "+v"(acc[ai][0][m][0]), "+v"(acc[ai][0][m][1]), "+v"(acc[ai][1][m][0]), "+v"(acc[ai][1][m][1]));
                if (m & 1) asm volatile("" ::: "memory"); }
        const bool bad1 = bad;
        bad = st2.run(acc, u, wr, wc, fr, fq, lds, wid, lane) || bad;
#pragma unroll
        for (int ai = 0; ai < 2; ++ai)
#pragma unroll
            for (int m = 0; m < 4; ++m) { const int r = ai * HALF + wr * 64 + m * 16 + fr; const f32x2v sr = S[r]; const size_t off = (size_t)(u.pm * BM + r) * ldc + col0;
#pragma unroll
                for (int bj = 0; bj < 2; ++bj)
#pragma unroll
                    for (int n = 0; n < 2; ++n) { const f32x4 x1 = acc[ai][bj][m][n]; *(f32x4*)(out + off + bj * HALF + n * 16) = bad1 ? (f32x4){qnan, qnan, qnan, qnan} : x1;
                        const f32x4 o = (x1 - sr.x) * sr.y; u32x2v w; w.x = cvt_pk_bf16(o[0], o[1]); w.y = cvt_pk_bf16(o[2], o[3]);
                        if (bad) { w.x = 0x7fc07fc0u; w.y = 0x7fc07fc0u; } *(u32x2v*)(xn + off + bj * HALF + n * 16) = w; }
                asm volatile("" ::: "memory"); }
    }
};

template <class Epi, class Sched, bool STAMP = false>
__device__ __forceinline__ void gemm_phase(PG8_LAS unsigned char* lds, const Gemm g, const Sched& S, const Epi& E, unsigned long long* stamps) {
    int tid_ = threadIdx.x; asm volatile("" : "+v"(tid_));
    const int tid = tid_, wid = __builtin_amdgcn_readfirstlane(tid >> 6), lane = tid & 63, wr = wid >> 2, wc = wid & 3, fr = lane & 15, fq = lane >> 4;
    const int K = g.K, nt = K / BK;
    int ts_lo = 0, ts_hi = 0, nts = 0; const unsigned long long rt_entry = STAMP ? (unsigned long long)wall_clock64() : 0ull;
#define PG8_STAMP() do { if (STAMP && wid == 0 && nts < 64) { const unsigned long long _c = (unsigned long long)clock64(); \
        ts_lo = (lane == nts) ? (int)(unsigned)_c : ts_lo; ts_hi = (lane == nts) ? (int)(unsigned)(_c >> 32) : ts_hi; ++nts; } } while (0)
    PG8_STAMP();
    unsigned voffA[2], voffB[2];
#pragma unroll
    for (int i = 0; i < 2; ++i) { int R, C; stage_rc(tid * 16 + i * 8192, R, C); const int Rb = Epi::PERM ? ((R & ~31) + perm32(R & 31)) : R;
        voffA[i] = (unsigned)(R * K + C) * 2u; voffB[i] = (unsigned)(Rb * K + C) * 2u; }
    const size_t kstep = (size_t)(BK * 2);
    const size_t hstep = (size_t)HALF * K * 2;
    const size_t tstep = 2 * hstep;
    const unsigned ldsw = (unsigned)wid * 1024u;
    const int aoff = lds_byte(wr * 64 + fr, fq * 8), boff = lds_byte(wc * 32 + fr, fq * 8);
#define PG8_SA(b, h) (((b) * 2 + (h)) * HTB)
#define PG8_SB(b, h) ((4 + (b) * 2 + (h)) * HTB)
#define PG8_STAGE(bufoff, gbase, voff) do { _Pragma("unroll") for (int _i = 0; _i < 2; ++_i) \
        __builtin_amdgcn_global_load_lds((const unsigned*)((const char*)(gbase) + (voff)[_i]), (PG8_LAS unsigned*)(lds + (bufoff) + ldsw + _i * 8192), 16, 0, 0); } while (0)
#define PG8_LDA(dst, b, h) do { _Pragma("unroll") for (int m = 0; m < 4; ++m) _Pragma("unroll") for (int k = 0; k < 2; ++k) dst[m][k] = *(const PG8_LAS bf16x8*)(lds + PG8_SA(b, h) + aoff + m * 2048 + k * 1024); } while (0)
#define PG8_LDB(dst, b, h) do { _Pragma("unroll") for (int n = 0; n < 2; ++n) _Pragma("unroll") for (int k = 0; k < 2; ++k) dst[n][k] = *(const PG8_LAS bf16x8*)(lds + PG8_SB(b, h) + boff + n * 2048 + k * 1024); } while (0)
#define PG8_MMA(ai, bj, At, Bt) do { __builtin_amdgcn_s_setprio(1); _Pragma("unroll") for (int m = 0; m < 4; ++m) _Pragma("unroll") for (int n = 0; n < 2; ++n) _Pragma("unroll") for (int k = 0; k < 2; ++k) \
        acc[ai][bj][m][n] = __builtin_amdgcn_mfma_f32_16x16x32_bf16(Bt[n][k], At[m][k], acc[ai][bj][m][n], 0, 0, 0); __builtin_amdgcn_s_setprio(0); } while (0)
#define PG8_WAIT_V(n) asm volatile("s_waitcnt vmcnt(" #n ")" ::: "memory")
#define PG8_WAIT_L(n) asm volatile("s_waitcnt lgkmcnt(" #n ")" ::: "memory")
#define PG8_BAR __builtin_amdgcn_s_barrier()
#define PG8_SCHED __builtin_amdgcn_sched_barrier(0)
    Unit cur, nxt; int ui = 0;
    if (!S.next(0, cur)) return;
    f32x4 acc[2][2][4][2];
#pragma unroll
    for (int a = 0; a < 2; ++a)
#pragma unroll
        for (int b = 0; b < 2; ++b)
#pragma unroll
            for (int m = 0; m < 4; ++m)
#pragma unroll
                for (int n = 0; n < 2; ++n) acc[a][b][m][n] = (f32x4){0.f, 0.f, 0.f, 0.f};
    bf16x8 At[4][2], B0[2][2], B1[2][2];
    const char* cA = (const char*)g.A + (size_t)cur.pm * tstep; const char* cB = (const char*)g.Bt + (size_t)cur.pn * tstep;
    S.a_ready(cur);
    PG8_STAGE(PG8_SB(0, 0), cB, voffB); PG8_STAGE(PG8_SA(0, 0), cA, voffA); PG8_STAGE(PG8_SB(0, 1), cB + hstep, voffB); PG8_STAGE(PG8_SA(0, 1), cA + hstep, voffA);
    if (wr == 1) PG8_BAR;
    PG8_WAIT_V(4); PG8_BAR;
    PG8_STAGE(PG8_SB(1, 0), cB + kstep, voffB); PG8_STAGE(PG8_SA(1, 0), cA + kstep, voffA); PG8_STAGE(PG8_SB(1, 1), cB + hstep + kstep, voffB);
    PG8_WAIT_V(6); PG8_BAR;
    PG8_STAMP();
    for (;;) {
        const bool has_next = S.next(ui + 1, nxt);
        const char* nA = has_next ? (const char*)g.A + (size_t)nxt.pm * tstep : cA; const char* nB = has_next ? (const char*)g.Bt + (size_t)nxt.pn * tstep : cB;
        for (int t = 0; t < nt; t += 2) {
            const bool last = (t == nt - 2);
            const char* a1 = cA + (size_t)(t + 1) * kstep;
            const char* a2 = last ? nA : cA + (size_t)(t + 2) * kstep; const char* b2 = last ? nB : cB + (size_t)(t + 2) * kstep;
            const char* a3 = a2 + kstep; const char* b3 = b2 + kstep;
            if (last && has_next) S.a_ready(nxt);
            PG8_LDB(B0, 0, 0); PG8_SCHED; PG8_LDA(At, 0, 0); PG8_STAGE(PG8_SA(1, 1), a1 + hstep, voffA);
            PG8_WAIT_L(8); PG8_BAR; PG8_WAIT_L(0); PG8_MMA(0, 0, At, B0); PG8_BAR; PG8_SCHED;
            PG8_LDB(B1, 0, 1); PG8_STAGE(PG8_SB(0, 0), b2, voffB);
            PG8_BAR; PG8_WAIT_L(0); PG8_MMA(0, 1, At, B1); PG8_BAR;
            PG8_LDA(At, 0, 1); PG8_STAGE(PG8_SA(0, 0), a2, voffA);
            PG8_BAR; PG8_WAIT_L(0); PG8_MMA(1, 0, At, B0); PG8_BAR; PG8_SCHED;
            PG8_STAGE(PG8_SB(0, 1), b2 + hstep, voffB);
            PG8_WAIT_V(6); PG8_BAR; PG8_MMA(1, 1, At, B1); PG8_BAR;
            PG8_LDB(B0, 1, 0); PG8_SCHED; PG8_LDA(At, 1, 0); PG8_STAGE(PG8_SA(0, 1), a2 + hstep, voffA);
            PG8_WAIT_L(8); PG8_BAR; PG8_WAIT_L(0); PG8_MMA(0, 0, At, B0); PG8_BAR; PG8_SCHED;
            PG8_LDB(B1, 1, 1); PG8_STAGE(PG8_SB(1, 0), b3, voffB);
            PG8_BAR; PG8_WAIT_L(0); PG8_MMA(0, 1, At, B1); PG8_BAR;
            PG8_LDA(At, 1, 1); PG8_STAGE(PG8_SA(1, 0), a3, voffA);
            PG8_BAR; PG8_WAIT_L(0); PG8_MMA(1, 0, At, B0); PG8_BAR; PG8_SCHED;
            PG8_STAGE(PG8_SB(1, 1), b3 + hstep, voffB);
            PG8_WAIT_V(6); PG8_BAR; PG8_MMA(1, 1, At, B1); PG8_BAR;
        }
        PG8_STAMP();
        if constexpr (!Epi::AFTER_DRAIN) { E(acc, cur, wr, wc, fr, fq); S.done(cur); }
        PG8_STAMP();
        if (!has_next) break;
#pragma unroll
        for (int a = 0; a < 2; ++a)
#pragma unroll
            for (int b = 0; b < 2; ++b)
#pragma unroll
                for (int m = 0; m < 4; ++m)
#pragma unroll
                    for (int n = 0; n < 2; ++n) acc[a][b][m][n] = (f32x4){0.f, 0.f, 0.f, 0.f};
        cur = nxt; cA = nA; cB = nB; ++ui;
    }
    PG8_WAIT_V(0);
    if (wr == 0) PG8_BAR;
    PG8_BAR;
    if constexpr (Epi::AFTER_DRAIN) { E.fused(acc, cur, wr, wc, fr, fq, lds, wid, lane); S.done(cur); }
    PG8_STAMP();
    if (STAMP && wid == 0) { stamps[lane] = lane < nts ? (((unsigned long long)(unsigned)ts_hi << 32) | (unsigned)ts_lo) : 0ull;
        if (lane == 62) stamps[62] = rt_entry; if (lane == 63) stamps[63] = (unsigned long long)wall_clock64(); }
#undef PG8_STAMP
#undef PG8_SA
#undef PG8_SB
#undef PG8_STAGE
#undef PG8_LDA
#undef PG8_LDB
#undef PG8_MMA
#undef PG8_WAIT_V
#undef PG8_WAIT_L
#undef PG8_BAR
#undef PG8_SCHED
}
}

namespace cg = cooperative_groups;
namespace mk {
#define LAS __attribute__((address_space(3)))
typedef unsigned short bf16_t;
typedef short bf16x8 __attribute__((ext_vector_type(8)));
typedef float f32x4 __attribute__((ext_vector_type(4)));
typedef float f32x2 __attribute__((ext_vector_type(2)));
typedef unsigned u32x4 __attribute__((ext_vector_type(4)));
typedef unsigned u32x2 __attribute__((ext_vector_type(2)));

constexpr int SEQ = 2048, MTOK = 32768, DM = 1024, DFF = 4096, DMIX = 2048;
constexpr int NPROJ = 4608, DINP = 4632, NH = 24;
constexpr float ALPHA = 1.189207115002721f, LN_EPS = 1e-5f, RMS_EPS = 1e-5f;
constexpr int NTHREADS = 512;
constexpr int LDS_BYTES = 158720;

constexpr size_t WS_WIN   = 0;
constexpr size_t WS_WOUT  = WS_WIN   + 4608ull * 1024 * 2;
constexpr size_t WS_WFF1  = WS_WOUT  + 1024ull * 2048 * 2;
constexpr size_t WS_WFF2  = WS_WFF1  + 4096ull * 1024 * 2;
constexpr size_t WS_WPOOL = WS_WFF2  + 4096ull * 1024 * 2;
constexpr size_t WS_DT    = WS_WPOOL + 4ull * 128 * 128 * 2;
constexpr size_t WS_SSQ   = WS_DT    + 16ull * 24 * 2048 * 4;
constexpr size_t WS_DTV   = WS_SSQ   + 32768ull * 24 * 4;
constexpr size_t WS_ACS   = WS_DTV   + 16ull * 24 * 2048 * 4;
constexpr size_t WS_WL    = WS_ACS   + 16ull * 24 * 2048 * 4;
constexpr size_t WS_UZ    = WS_WL    + 16ull * 24 * 2048 * 4;
constexpr size_t WS_XBC   = WS_UZ    + 32768ull * 2048 * 2;
constexpr size_t WS_BT    = WS_XBC   + 32768ull * 2560 * 2;
constexpr size_t WS_BC    = WS_BT    + 16ull * 512 * 2048 * 2;
constexpr size_t WS_CTL   = WS_BC    + 32768ull * 1024 * 2;
constexpr size_t WS_END   = WS_CTL   + 16384;
constexpr size_t WS_H1    = WS_UZ;
constexpr size_t WS_HB    = WS_BT;

struct Params { const float* in[17]; float* out; unsigned char* ws; int ph_lo, ph_hi; };

__device__ __forceinline__ unsigned pk_bf16(float lo, float hi) { unsigned r; asm("v_cvt_pk_bf16_f32 %0, %1, %2" : "=v"(r) : "v"(lo), "v"(hi)); return r; }
__device__ __forceinline__ float bf_lo(unsigned u) { return __uint_as_float(u << 16); }
__device__ __forceinline__ float bf_hi(unsigned u) { return __uint_as_float(u & 0xffff0000u); }
__device__ __forceinline__ bf16_t f2bf(float f) { return (bf16_t)(pk_bf16(f, 0.f) & 0xffffu); }
__device__ __forceinline__ bf16x8 as_bf16x8(u32x4 v) { union { u32x4 u; bf16x8 b; } c; c.u = v; return c.b; }
__device__ __forceinline__ f32x4 mfma16(bf16x8 a, bf16x8 b, f32x4 c) { return __builtin_amdgcn_mfma_f32_16x16x32_bf16(a, b, c, 0, 0, 0); }
__device__ __forceinline__ float silu(float v) { return v * __builtin_amdgcn_rcpf(1.0f + __expf(-v)); }
__device__ __forceinline__ float softplus(float v) { return fmaxf(v, 0.f) + log1pf(__expf(-fabsf(v))); }

constexpr int PT = 136;
__device__ __forceinline__ bf16x8 ldfrag(const LAS bf16_t* base, int row, int k) { return *(const LAS bf16x8*)(base + row * PT + k); }

__device__ __forceinline__ void transpose_tile(const float* src, int ldsrc, bf16_t* dst, int lddst, int k0, int n0, LAS float* tile, int tid) {
    { const int i = tid >> 4, j4 = (tid & 15) * 4;
#pragma unroll
      for (int h = 0; h < 2; ++h) { const f32x4 v = *(const f32x4*)(src + (size_t)(k0 + i + 32 * h) * ldsrc + n0 + j4);
          tile[(i + 32 * h) * 65 + j4 + 0] = v[0]; tile[(i + 32 * h) * 65 + j4 + 1] = v[1]; tile[(i + 32 * h) * 65 + j4 + 2] = v[2]; tile[(i + 32 * h) * 65 + j4 + 3] = v[3]; } }
    __syncthreads();
    { const int n = tid >> 3, kk = (tid & 7) * 8; float e[8];
#pragma unroll
      for (int t = 0; t < 8; ++t) e[t] = tile[(kk + t) * 65 + n];
      u32x4 o; o.x = pk_bf16(e[0], e[1]); o.y = pk_bf16(e[2], e[3]); o.z = pk_bf16(e[4], e[5]); o.w = pk_bf16(e[6], e[7]);
      *(u32x4*)(dst + (size_t)(n0 + n) * lddst + k0 + kk) = o; }
    __syncthreads();
}

__device__ __forceinline__ void phase0(const Params& P, LAS unsigned char* lds) {
    int tid_ = threadIdx.x; asm volatile("" : "+v"(tid_)); const int tid = tid_, lane = tid & 63, wid = tid >> 6, r = lane & 15, q = lane >> 4;
    const float* x = P.in[0]; const float* w_in = P.in[1];
    bf16_t* xb = (bf16_t*)P.out;
    LAS bf16_t* sW = (LAS bf16_t*)lds;
    for (int i = tid; i < 32 * 1024; i += NTHREADS) { const int k = i >> 5, h = i & 31; const float v = h < NH ? w_in[(size_t)k * DINP + NPROJ + h] : 0.f; sW[h * 1032 + k] = f2bf(v); }
    __syncthreads();
    float* dt = (float*)(P.ws + WS_DT);
    for (int grp = blockIdx.x * 8 + wid; grp < MTOK / 16; grp += gridDim.x * 8) {
        const int row0 = grp * 16;
        const float* xr = x + (size_t)(row0 + r) * DM + 8 * q;
        bf16_t* xo = xb + (size_t)(row0 + r) * DM + 8 * q;
        f32x4 a0 = {0.f, 0.f, 0.f, 0.f}, a1 = {0.f, 0.f, 0.f, 0.f};
#pragma unroll 4
        for (int k0 = 0; k0 < DM; k0 += 32) {
            const f32x4 v0 = *(const f32x4*)(xr + k0), v1 = *(const f32x4*)(xr + k0 + 4);
            u32x4 pk; pk.x = pk_bf16(v0[0], v0[1]); pk.y = pk_bf16(v0[2], v0[3]); pk.z = pk_bf16(v1[0], v1[1]); pk.w = pk_bf16(v1[2], v1[3]);
            *(u32x4*)(xo + k0) = pk;
            const bf16x8 af = as_bf16x8(pk);
            const bf16x8 b0 = *(const LAS bf16x8*)(sW + r * 1032 + k0 + 8 * q), b1 = *(const LAS bf16x8*)(sW + (16 + r) * 1032 + k0 + 8 * q);
            a0 = mfma16(af, b0, a0); a1 = mfma16(af, b1, a1);
        }
        const int b = row0 >> 11, pos = (row0 & 2047) + 4 * q;
        *(f32x4*)(dt + (size_t)(b * NH + r) * SEQ + pos) = a0;
        if (r < 8) *(f32x4*)(dt + (size_t)(b * NH + 16 + r) * SEQ + pos) = a1;
    }
    LAS float* tile = (LAS float*)(lds + 69632);
    unsigned char* ws = P.ws;
    const int n0j = 16 * 72, n1j = 32 * 16, n2j = 16 * 64, n3j = 64 * 16, total = n0j + n1j + n2j + n3j + 16;
    for (int t = blockIdx.x; t < total; t += gridDim.x) {
        int u = t;
        if (u < n0j) { transpose_tile(P.in[1], DINP, (bf16_t*)(ws + WS_WIN), 1024, (u / 72) * 64, (u % 72) * 64, tile, tid); continue; }
        u -= n0j;
        if (u < n1j) { transpose_tile(P.in[10], 1024, (bf16_t*)(ws + WS_WOUT), 2048, (u / 16) * 64, (u % 16) * 64, tile, tid); continue; }
        u -= n1j;
        if (u < n2j) { transpose_tile(P.in[13], 4096, (bf16_t*)(ws + WS_WFF1), 1024, (u / 64) * 64, (u % 64) * 64, tile, tid); continue; }
        u -= n2j;
        if (u < n3j) { transpose_tile(P.in[14], 1024, (bf16_t*)(ws + WS_WFF2), 4096, (u / 16) * 64, (u % 16) * 64, tile, tid); continue; }
        u -= n3j;
        { const int g = u >> 2, tt = u & 3; transpose_tile(P.in[2] + (size_t)g * 16384, 128, (bf16_t*)(ws + WS_WPOOL) + (size_t)g * 16384, 128, (tt >> 1) * 64, (tt & 1) * 64, tile, tid); }
    }
}

__device__ __forceinline__ void phase_conv(const Params& P, LAS unsigned char* lds) {
    int tid_ = threadIdx.x; asm volatile("" : "+v"(tid_)); const int tid = tid_, lane = tid & 63, wid = tid >> 6;
    const bf16_t* xbc = (const bf16_t*)(P.ws + WS_XBC);
    bf16_t* BC = (bf16_t*)(P.ws + WS_BC); bf16_t* BT = (bf16_t*)(P.ws + WS_BT); bf16_t* XT = (bf16_t*)P.out;
    const float* conv_w = P.in[4]; const float* conv_b = P.in[5];
    LAS bf16_t* sT = (LAS bf16_t*)lds;
    const int co = tid & 31, tg = tid >> 5;
    for (int item = blockIdx.x; item < 10 * 256; item += gridDim.x) {
        const int strip = item % 10, tile = item / 10, t0 = tile * 128, b = t0 >> 11, pos0 = t0 & 2047;
        const int c0 = strip * 256 + co * 8;
        const bf16_t* src = xbc + (size_t)(t0 + 8 * tg) * 2560 + c0;
        u32x4 rw[11];
        const bool halo = !(tg == 0 && pos0 == 0);
#pragma unroll
        for (int i = 0; i < 3; ++i) { rw[i] = (u32x4){0u, 0u, 0u, 0u}; if (halo) rw[i] = *(const u32x4*)(src + (ptrdiff_t)(i - 3) * 2560); }
#pragma unroll
        for (int i = 3; i < 11; ++i) rw[i] = *(const u32x4*)(src + (size_t)(i - 3) * 2560);
        float w0[8], w1[8], w2[8], w3[8], bi[8];
        { const f32x4 a = *(const f32x4*)(conv_w + c0), bq = *(const f32x4*)(conv_w + c0 + 4);
          const f32x4 c = *(const f32x4*)(conv_w + 2560 + c0), d = *(const f32x4*)(conv_w + 2560 + c0 + 4);
          const f32x4 e = *(const f32x4*)(conv_w + 5120 + c0), f = *(const f32x4*)(conv_w + 5120 + c0 + 4);
          const f32x4 g = *(const f32x4*)(conv_w + 7680 + c0), h = *(const f32x4*)(conv_w + 7680 + c0 + 4);
          const f32x4 bb0 = *(const f32x4*)(conv_b + c0), bb1 = *(const f32x4*)(conv_b + c0 + 4);
#pragma unroll
          for (int j = 0; j < 4; ++j) { w0[j] = a[j]; w0[j + 4] = bq[j]; w1[j] = c[j]; w1[j + 4] = d[j]; w2[j] = e[j]; w2[j + 4] = f[j]; w3[j] = g[j]; w3[j + 4] = h[j]; bi[j] = bb0[j]; bi[j + 4] = bb1[j]; } }
        float p3[8], p2[8], p1[8];
#pragma unroll
        for (int j = 0; j < 4; ++j) { p3[2 * j] = bf_lo(rw[0][j]); p3[2 * j + 1] = bf_hi(rw[0][j]); p2[2 * j] = bf_lo(rw[1][j]); p2[2 * j + 1] = bf_hi(rw[1][j]); p1[2 * j] = bf_lo(rw[2][j]); p1[2 * j + 1] = bf_hi(rw[2][j]); }
        unsigned tr[8][4]; float ev[8];
        bf16_t* dstR = BC + (size_t)(t0 + 8 * tg) * 1024 + (strip - 6) * 256 + co * 8;
#pragma unroll
        for (int tk = 0; tk < 8; ++tk) {
            float cur[8], a[8];
#pragma unroll
            for (int j = 0; j < 4; ++j) { cur[2 * j] = bf_lo(rw[3 + tk][j]); cur[2 * j + 1] = bf_hi(rw[3 + tk][j]); }
#pragma unroll
            for (int j = 0; j < 8; ++j) { const float y = bi[j] + w0[j] * p3[j] + w1[j] * p2[j] + w2[j] * p1[j] + w3[j] * cur[j]; a[j] = silu(y); p3[j] = p2[j]; p2[j] = p1[j]; p1[j] = cur[j]; }
            if (strip >= 6) { u32x4 o; o.x = pk_bf16(a[0], a[1]); o.y = pk_bf16(a[2], a[3]); o.z = pk_bf16(a[4], a[5]); o.w = pk_bf16(a[6], a[7]); *(u32x4*)(dstR + (size_t)tk * 1024) = o; }
            if (tk & 1) {
#pragma unroll
                for (int j = 0; j < 8; ++j) tr[j][tk >> 1] = pk_bf16(ev[j], a[j]);
            } else {
#pragma unroll
                for (int j = 0; j < 8; ++j) ev[j] = a[j];
            }
        }
        if (strip < 8) {
#pragma unroll
            for (int j = 0; j < 8; ++j) { const int row = 8 * co + j; u32x4 o; o.x = tr[j][0]; o.y = tr[j][1]; o.z = tr[j][2]; o.w = tr[j][3];
                *(LAS u32x4*)(sT + row * 128 + ((tg ^ (co & 15)) * 8)) = o; }
            __syncthreads();
            bf16_t* dstT = strip < 6 ? XT + ((size_t)b * 1536 + strip * 256) * SEQ + pos0 : BT + ((size_t)b * 512 + (strip - 6) * 256) * SEQ + pos0;
#pragma unroll
            for (int i = 0; i < 8; ++i) { const int id = tid + NTHREADS * i, row = id >> 4, k = id & 15;
                const u32x4 v = *(const LAS u32x4*)(sT + row * 128 + ((k ^ ((row >> 3) & 15)) * 8));
                *(u32x4*)(dstT + (size_t)row * SEQ + 8 * k) = v; }
            __syncthreads();
        }
    }
    { const float* dtr = (const float*)(P.ws + WS_DT); float* dtv = (float*)(P.ws + WS_DTV); float* acs = (float*)(P.ws + WS_ACS); float* wl = (float*)(P.ws + WS_WL);
      const int nW = gridDim.x * 8;
      for (int it = blockIdx.x * 8 + wid; it < 16 * NH * 16; it += nW) {
          const int bh = it >> 4, c = it & 15, h = bh % NH;
          const float dtb = P.in[6][h], a_neg = -__expf(P.in[7][h]);
          const size_t off = (size_t)bh * SEQ + c * 128 + 2 * lane;
          const f32x2 d = *(const f32x2*)(dtr + off);
          const float dt0 = softplus(d.x + dtb), dt1 = softplus(d.y + dtb);
          const float a0 = dt0 * a_neg, a1 = dt1 * a_neg;
          float s = a0 + a1;
#pragma unroll
          for (int o = 1; o < 64; o <<= 1) { const float t = __shfl_up(s, o); if (lane >= o) s += t; }
          const float acs1 = s, acs0 = s - a1, aend = __shfl(s, 63);
          *(f32x2*)(dtv + off) = (f32x2){dt0, dt1}; *(f32x2*)(acs + off) = (f32x2){acs0, acs1};
          *(f32x2*)(wl + off) = (f32x2){dt0 * __expf(aend - acs0), dt1 * __expf(aend - acs1)};
      } }
}

constexpr int L_C = 0, L_B = 34816, L_BT = 69632, L_XT = 104448, L_XW = 121856, L_S = 139264, L_DT = 156672, L_ACS = L_DT + 512;
#define SSD_PREFETCH_Z(cc) do { const size_t tk0_ = (size_t)b * SEQ + (cc) * 128; \
    _Pragma("unroll") for (int pt = 0; pt < 4; ++pt) gZ[pt] = *(const u32x2*)(uz + (tk0_ + 16 * wid + r) * 2048 + 512 + h * 64 + 16 * pt + 4 * q); } while (0)
#define SSD_PREFETCH(cc) do { const size_t tk0_ = (size_t)b * SEQ + (cc) * 128; \
    _Pragma("unroll") for (int i = 0; i < 4; ++i) { const int id = tid + NTHREADS * i, row = id >> 4, c8 = (id & 15) * 8; \
        gC[i] = *(const u32x4*)(BC + (tk0_ + row) * 1024 + 512 + g * 128 + c8); gB[i] = *(const u32x4*)(BC + (tk0_ + row) * 1024 + g * 128 + c8); \
        gBT[i] = *(const u32x4*)(BT + ((size_t)b * 512 + g * 128 + row) * SEQ + (cc) * 128 + c8); } \
    _Pragma("unroll") for (int i = 0; i < 2; ++i) { const int id = tid + NTHREADS * i, row = id >> 4, c8 = (id & 15) * 8; \
        gX[i] = *(const u32x4*)(XT + ((size_t)b * 1536 + h * 64 + row) * SEQ + (cc) * 128 + c8); } \
    { const int c8 = (tid & 15) * 8; gW[0] = *(const f32x4*)(wlp + (cc) * 128 + c8); gW[1] = *(const f32x4*)(wlp + (cc) * 128 + c8 + 4); } \
    if (wid == 0) { gD = *(const f32x2*)(dtp + (cc) * 128 + 2 * lane); gA = *(const f32x2*)(acp + (cc) * 128 + 2 * lane); } } while (0)

__device__ __forceinline__ void ssd_item(const Params& P, LAS unsigned char* lds, int item) {
    int tid_ = threadIdx.x; asm volatile("" : "+v"(tid_)); const int tid = tid_, lane = tid & 63, wid = __builtin_amdgcn_readfirstlane(tid >> 6), r = lane & 15, q = lane >> 4;
    const int b = item / NH, h = item % NH, g = h / 6;
    const bf16_t* BC = (const bf16_t*)(P.ws + WS_BC); const bf16_t* BT = (const bf16_t*)(P.ws + WS_BT); const bf16_t* XT = (const bf16_t*)P.out;
    const bf16_t* uz = (const bf16_t*)(P.ws + WS_UZ); bf16_t* mixed = (bf16_t*)(P.ws + WS_XBC); float* ssq = (float*)(P.ws + WS_SSQ);
    const float* dtp = (const float*)(P.ws + WS_DTV) + (size_t)(b * NH + h) * SEQ; const float* acp = (const float*)(P.ws + WS_ACS) + (size_t)(b * NH + h) * SEQ;
    const float* wlp = (const float*)(P.ws + WS_WL) + (size_t)(b * NH + h) * SEQ;
    const float Dh = P.in[8][h];
    LAS bf16_t* sC = (LAS bf16_t*)(lds + L_C); LAS bf16_t* sB = (LAS bf16_t*)(lds + L_B); LAS bf16_t* sBT = (LAS bf16_t*)(lds + L_BT);
    LAS bf16_t* sXT = (LAS bf16_t*)(lds + L_XT); LAS bf16_t* sXW = (LAS bf16_t*)(lds + L_XW); LAS bf16_t* sS = (LAS bf16_t*)(lds + L_S);
    LAS float* sDt = (LAS float*)(lds + L_DT); LAS float* sAcs = (LAS float*)(lds + L_ACS);
    const int nb = wid >> 1, pb = wid & 1, lrow = 16 * wid + r;
    f32x4 S[2][2];
#pragma unroll
    for (int i = 0; i < 2; ++i)
#pragma unroll
        for (int j = 0; j < 2; ++j) S[i][j] = (f32x4){0.f, 0.f, 0.f, 0.f};
    u32x4 gC[4], gB[4], gBT[4], gX[2]; f32x4 gW[2]; u32x2 gZ[4]; f32x2 gD = {0.f, 0.f}, gA = {0.f, 0.f};
    SSD_PREFETCH(0); SSD_PREFETCH_Z(0);
    for (int c = 0; c < 16; ++c) {
        const size_t tok0 = (size_t)b * SEQ + c * 128;
#pragma unroll
        for (int i = 0; i < 4; ++i) { const int id = tid + NTHREADS * i, row = id >> 4, c8 = (id & 15) * 8;
            *(LAS u32x4*)(sC + row * PT + c8) = gC[i]; *(LAS u32x4*)(sB + row * PT + c8) = gB[i]; *(LAS u32x4*)(sBT + row * PT + c8) = gBT[i]; }
#pragma unroll
        for (int i = 0; i < 2; ++i) { const int id = tid + NTHREADS * i, row = id >> 4, c8 = (id & 15) * 8;
            *(LAS u32x4*)(sXT + row * PT + c8) = gX[i];
            u32x4 o; o.x = pk_bf16(bf_lo(gX[i].x) * gW[0][0], bf_hi(gX[i].x) * gW[0][1]); o.y = pk_bf16(bf_lo(gX[i].y) * gW[0][2], bf_hi(gX[i].y) * gW[0][3]);
            o.z = pk_bf16(bf_lo(gX[i].z) * gW[1][0], bf_hi(gX[i].z) * gW[1][1]); o.w = pk_bf16(bf_lo(gX[i].w) * gW[1][2], bf_hi(gX[i].w) * gW[1][3]);
            *(LAS u32x4*)(sXW + row * PT + c8) = o; }
        if (wid == 0) { *(LAS f32x2*)(sDt + 2 * lane) = gD; *(LAS f32x2*)(sAcs + 2 * lane) = gA; }
#pragma unroll
        for (int i = 0; i < 2; ++i)
#pragma unroll
            for (int j = 0; j < 2; ++j) { u32x2 o; o.x = pk_bf16(S[i][j][0], S[i][j][1]); o.y = pk_bf16(S[i][j][2], S[i][j][3]);
                *(LAS u32x2*)(sS + (32 * pb + 16 * j + r) * PT + 32 * nb + 16 * i + 4 * q) = o; }
        __syncthreads();
        if (c + 1 < 16) SSD_PREFETCH(c + 1);
        bf16x8 cf[4];
#pragma unroll
        for (int ks = 0; ks < 4; ++ks) cf[ks] = ldfrag(sC, lrow, 32 * ks + 8 * q);
        const float acs_l = sAcs[lrow];
        unsigned mreg[8][2];
#pragma unroll
        for (int hb = 0; hb < 2; ++hb) {
            f32x4 cb[4];
#pragma unroll
            for (int sb = 0; sb < 4; ++sb) cb[sb] = (f32x4){0.f, 0.f, 0.f, 0.f};
#pragma unroll
            for (int ks = 0; ks < 4; ++ks)
#pragma unroll
                for (int sb = 0; sb < 4; ++sb) if (4 * hb + sb <= wid) { const bf16x8 bfr = ldfrag(sB, 16 * (4 * hb + sb) + r, 32 * ks + 8 * q); cb[sb] = mfma16(bfr, cf[ks], cb[sb]); }
#pragma unroll
            for (int sb = 0; sb < 4; ++sb) { const int sbb = 4 * hb + sb; mreg[sbb][0] = 0u; mreg[sbb][1] = 0u;
                if (sbb <= wid) {
                    const f32x4 as = *(const LAS f32x4*)(sAcs + 16 * sbb + 4 * q), ds = *(const LAS f32x4*)(sDt + 16 * sbb + 4 * q);
                    float mm[4];
#pragma unroll
                    for (int e = 0; e < 4; ++e) { const int s = 16 * sbb + 4 * q + e;
                        float v = cb[sb][e] * __expf(acs_l - as[e]) * ds[e];
                        v = (s <= lrow) ? v : 0.f; if (s == lrow) v += Dh; mm[e] = v; }
                    mreg[sbb][0] = pk_bf16(mm[0], mm[1]); mreg[sbb][1] = pk_bf16(mm[2], mm[3]);
                } }
        }
        f32x4 y[4];
#pragma unroll
        for (int pt = 0; pt < 4; ++pt) y[pt] = (f32x4){0.f, 0.f, 0.f, 0.f};
#pragma unroll
        for (int ks = 0; ks < 4; ++ks)
#pragma unroll
            for (int pt = 0; pt < 4; ++pt) { const bf16x8 sf = ldfrag(sS, 16 * pt + r, 32 * ks + 8 * q); y[pt] = mfma16(sf, cf[ks], y[pt]); }
        { const float el = __expf(acs_l);
#pragma unroll
          for (int pt = 0; pt < 4; ++pt) y[pt] *= el; }
#pragma unroll
        for (int ks = 0; ks < 4; ++ks) if (ks <= (wid >> 1)) {
            u32x4 mu; mu.x = mreg[2 * ks][0]; mu.y = mreg[2 * ks][1]; mu.z = mreg[2 * ks + 1][0]; mu.w = mreg[2 * ks + 1][1];
            const bf16x8 mf = as_bf16x8(mu);
#pragma unroll
            for (int pt = 0; pt < 4; ++pt) {
                const u32x2 xa = *(const LAS u32x2*)(sXT + (16 * pt + r) * PT + 32 * ks + 4 * q), xb = *(const LAS u32x2*)(sXT + (16 * pt + r) * PT + 32 * ks + 16 + 4 * q);
                u32x4 xu; xu.x = xa.x; xu.y = xa.y; xu.z = xb.x; xu.w = xb.y;
                y[pt] = mfma16(as_bf16x8(xu), mf, y[pt]); }
        }
        { const size_t tok = tok0 + lrow; float ss = 0.f;
#pragma unroll
          for (int pt = 0; pt < 4; ++pt) {
              const u32x2 zz = gZ[pt];
              const float v0 = y[pt][0] * silu(bf_lo(zz.x)), v1 = y[pt][1] * silu(bf_hi(zz.x)), v2 = y[pt][2] * silu(bf_lo(zz.y)), v3 = y[pt][3] * silu(bf_hi(zz.y));
              ss += v0 * v0 + v1 * v1 + v2 * v2 + v3 * v3;
              u32x2 o; o.x = pk_bf16(v0, v1); o.y = pk_bf16(v2, v3);
              *(u32x2*)(mixed + tok * 2048 + 512 + h * 64 + 16 * pt + 4 * q) = o; }
          ss += __shfl_xor(ss, 16); ss += __shfl_xor(ss, 32);
          if (q == 0) ssq[tok * NH + h] = ss; }
        if (c + 1 < 16) SSD_PREFETCH_Z(c + 1);
        { const float cd = __expf(sAcs[127]);
#pragma unroll
          for (int i = 0; i < 2; ++i)
#pragma unroll
              for (int j = 0; j < 2; ++j) S[i][j] *= cd; }
#pragma unroll
        for (int ks = 0; ks < 4; ++ks) {
            bf16x8 af[2], bfr[2];
#pragma unroll
            for (int i = 0; i < 2; ++i) { af[i] = ldfrag(sBT, 32 * nb + 16 * i + r, 32 * ks + 8 * q); bfr[i] = ldfrag(sXW, 32 * pb + 16 * i + r, 32 * ks + 8 * q); }
#pragma unroll
            for (int i = 0; i < 2; ++i)
#pragma unroll
                for (int j = 0; j < 2; ++j) S[i][j] = mfma16(af[i], bfr[j], S[i][j]);
        }
        __syncthreads();
    }
}
#undef SSD_PREFETCH
#undef SSD_PREFETCH_Z

constexpr int LP_U = 0, LP_D = 144 * PT * 2  , LP_W = LP_D + 128 * PT * 2  ;
__device__ __forceinline__ void pool_item(const Params& P, LAS unsigned char* lds, int item) {
    int tid_ = threadIdx.x; asm volatile("" : "+v"(tid_)); const int tid = tid_, lane = tid & 63, wid = __builtin_amdgcn_readfirstlane(tid >> 6), r = lane & 15, q = lane >> 4;
    const int g = item & 3, tile = item >> 2, t0 = tile * 128, pos0 = t0 & 2047, win = 2 << g;
    const bf16_t* uz = (const bf16_t*)(P.ws + WS_UZ); bf16_t* mixed = (bf16_t*)(P.ws + WS_XBC);
    const bf16_t* wp = (const bf16_t*)(P.ws + WS_WPOOL) + (size_t)g * 16384;
    const float* pscale = P.in[3];
    LAS bf16_t* sU = (LAS bf16_t*)(lds + LP_U); LAS bf16_t* sD = (LAS bf16_t*)(lds + LP_D); LAS bf16_t* sW = (LAS bf16_t*)(lds + LP_W);
    for (int id = tid; id < 144 * 16; id += NTHREADS) { const int row = id >> 4, c8 = (id & 15) * 8;
        u32x4 v; v.x = 0u; v.y = 0u; v.z = 0u; v.w = 0u;
        if (row >= 16 || pos0 != 0) v = *(const u32x4*)(uz + ((size_t)t0 + row - 16) * 2048 + g * 128 + c8);
        *(LAS u32x4*)(sU + row * PT + c8) = v; }
#pragma unroll
    for (int i = 0; i < 4; ++i) { const int id = tid + NTHREADS * i, row = id >> 4, c8 = (id & 15) * 8; *(LAS u32x4*)(sW + row * PT + c8) = *(const u32x4*)(wp + row * 128 + c8); }
    __syncthreads();
    { const int cp = tid & 63, seg = tid >> 6;
      float s0 = 0.f, s1 = 0.f;
      for (int k = 1; k < win; ++k) { const unsigned v = *(const LAS unsigned*)(sU + (16 * seg + 16 - k) * PT + 2 * cp); s0 += bf_lo(v); s1 += bf_hi(v); }
      for (int t = 0; t < 16; ++t) { const int tl = 16 * seg + t;
          const unsigned v = *(const LAS unsigned*)(sU + (tl + 16) * PT + 2 * cp); const float u0 = bf_lo(v), u1 = bf_hi(v);
          s0 += u0; s1 += u1;
          const int pos = pos0 + tl; const float inv = 1.0f / (float)((pos + 1) < win ? (pos + 1) : win);
          *(LAS unsigned*)(sD + tl * PT + 2 * cp) = pk_bf16(s0 * inv - u0, s1 * inv - u1);
          const unsigned o = *(const LAS unsigned*)(sU + (tl + 17 - win) * PT + 2 * cp); s0 -= bf_lo(o); s1 -= bf_hi(o); } }
    __syncthreads();
    f32x4 acc[8];
#pragma unroll
    for (int db = 0; db < 8; ++db) acc[db] = (f32x4){0.f, 0.f, 0.f, 0.f};
#pragma unroll
    for (int ks = 0; ks < 4; ++ks) { const bf16x8 df = ldfrag(sD, 16 * wid + r, 32 * ks + 8 * q);
#pragma unroll
        for (int db = 0; db < 8; ++db) { const bf16x8 wf = ldfrag(sW, 16 * db + r, 32 * ks + 8 * q); acc[db] = mfma16(wf, df, acc[db]); } }
    { const size_t tok = (size_t)t0 + 16 * wid + r;
#pragma unroll
      for (int db = 0; db < 8; ++db) { const f32x4 sc = *(const f32x4*)(pscale + g * 128 + 16 * db + 4 * q);
          u32x2 o; o.x = pk_bf16(acc[db][0] * sc[0], acc[db][1] * sc[1]); o.y = pk_bf16(acc[db][2] * sc[2], acc[db][3] * sc[3]);
          *(u32x2*)(mixed + tok * 2048 + g * 128 + 16 * db + 4 * q) = o; } }
    __syncthreads();
}

__device__ __forceinline__ void phase_mix(const Params& P, LAS unsigned char* lds) {
    const int G = gridDim.x, bid = blockIdx.x;
    for (int it = bid; it < 16 * NH; it += G) ssd_item(P, lds, it);
    const int lo = (16 * NH) % G, np = G - lo;
    if (bid >= lo) for (int pi = bid - lo; pi < 1024; pi += np) pool_item(P, lds, pi);
}

__device__ __forceinline__ void phase_rms(const Params& P) {
    int tid_ = threadIdx.x; asm volatile("" : "+v"(tid_)); const int tid = tid_, lane = tid & 63, wid = tid >> 6, nW = gridDim.x * 8;
    bf16_t* mixed = (bf16_t*)(P.ws + WS_XBC); const float* ssq = (const float*)(P.ws + WS_SSQ); const float* nw = P.in[9];
    for (int tok = blockIdx.x * 8 + wid; tok < MTOK; tok += nW) {
        bf16_t* p = mixed + (size_t)tok * 2048 + 512; const float* sq = ssq + (size_t)tok * NH;
#pragma unroll
        for (int i = 0; i < 3; ++i) { const int ci = lane + 64 * i, grp = ci / 48;
            const float s = (sq[grp * 6] + sq[grp * 6 + 1]) + (sq[grp * 6 + 2] + sq[grp * 6 + 3]) + (sq[grp * 6 + 4] + sq[grp * 6 + 5]);
            const float sc = 1.0f / sqrtf(s * (1.0f / 384.0f) + RMS_EPS);
            const u32x4 v = *(const u32x4*)(p + ci * 8); const f32x4 wa = *(const f32x4*)(nw + ci * 8), wb = *(const f32x4*)(nw + ci * 8 + 4);
            u32x4 o; o.x = pk_bf16(bf_lo(v.x) * sc * wa[0], bf_hi(v.x) * sc * wa[1]); o.y = pk_bf16(bf_lo(v.y) * sc * wa[2], bf_hi(v.y) * sc * wa[3]);
            o.z = pk_bf16(bf_lo(v.z) * sc * wb[0], bf_hi(v.z) * sc * wb[1]); o.w = pk_bf16(bf_lo(v.w) * sc * wb[2], bf_hi(v.w) * sc * wb[3]);
            *(u32x4*)(p + ci * 8) = o; }
    }
}

__device__ __forceinline__ void phase_ln(const float* gam, const float* bet, float* io, bf16_t* ob) {
    int tid_ = threadIdx.x; asm volatile("" : "+v"(tid_)); const int tid = tid_, lane = tid & 63, wid = tid >> 6, nW = gridDim.x * 8;
    f32x4 gg[4], bb[4];
#pragma unroll
    for (int j = 0; j < 4; ++j) { gg[j] = *(const f32x4*)(gam + 4 * lane + 256 * j); bb[j] = *(const f32x4*)(bet + 4 * lane + 256 * j); }
    for (int row = blockIdx.x * 8 + wid; row < MTOK; row += nW) {
        float* p = io + (size_t)row * DM + 4 * lane;
        f32x4 v[4]; float s = 0.f;
#pragma unroll
        for (int j = 0; j < 4; ++j) { v[j] = *(const f32x4*)(p + 256 * j); s += (v[j][0] + v[j][1]) + (v[j][2] + v[j][3]); }
#pragma unroll
        for (int o = 1; o < 64; o <<= 1) s += __shfl_xor(s, o);
        const float mean = s * (1.0f / 1024.0f); float qq = 0.f;
#pragma unroll
        for (int j = 0; j < 4; ++j) { v[j] = v[j] - mean; qq += (v[j][0] * v[j][0] + v[j][1] * v[j][1]) + (v[j][2] * v[j][2] + v[j][3] * v[j][3]); }
#pragma unroll
        for (int o = 1; o < 64; o <<= 1) qq += __shfl_xor(qq, o);
        const float rstd = 1.0f / sqrtf(qq * (1.0f / 1024.0f) + LN_EPS);
#pragma unroll
        for (int j = 0; j < 4; ++j) { const f32x4 o = v[j] * rstd * gg[j] + bb[j]; *(f32x4*)(p + 256 * j) = o;
            if (ob) { u32x2 w; w.x = pk_bf16(o[0], o[1]); w.y = pk_bf16(o[2], o[3]); *(u32x2*)(ob + (size_t)row * DM + 4 * lane + 256 * j) = w; } }
    }
}

struct EpiProj {
    static constexpr bool PERM = true, AFTER_DRAIN = false;
    bf16_t* uz; bf16_t* xbc;
    __device__ __forceinline__ void operator()(const pg8::f32x4 (&acc)[2][2][4][2], const pg8::Unit& u, int wr, int wc, int fr, int fq) const {
        const int row0 = u.pm * 256 + wr * 64 + fr; int colt = u.pn * 256; bf16_t* base = uz; int ldc = 2048;
        if (colt >= 2048) { base = xbc; ldc = 2560; colt -= 2048; }
        const int col0 = colt + wc * 32 + 8 * fq;
#pragma unroll
        for (int ai = 0; ai < 2; ++ai)
#pragma unroll
            for (int m = 0; m < 4; ++m) { bf16_t* rowp = base + (size_t)(row0 + ai * 128 + m * 16) * ldc + col0;
#pragma unroll
                for (int bj = 0; bj < 2; ++bj) { const pg8::f32x4 v0 = acc[ai][bj][m][0], v1 = acc[ai][bj][m][1];
                    u32x4 w; w.x = pk_bf16(v0[0], v0[1]); w.y = pk_bf16(v0[2], v0[3]); w.z = pk_bf16(v1[0], v1[1]); w.w = pk_bf16(v1[2], v1[3]);
                    *(u32x4*)(rowp + bj * 128) = w; } }
    }
};
struct EpiRelu2 {
    static constexpr bool PERM = true, AFTER_DRAIN = false;
    bf16_t* o;
    __device__ __forceinline__ void operator()(const pg8::f32x4 (&acc)[2][2][4][2], const pg8::Unit& u, int wr, int wc, int fr, int fq) const {
        const int row0 = u.pm * 256 + wr * 64 + fr, col0 = u.pn * 256 + wc * 32 + 8 * fq;
#pragma unroll
        for (int ai = 0; ai < 2; ++ai)
#pragma unroll
            for (int m = 0; m < 4; ++m) { bf16_t* rowp = o + (size_t)(row0 + ai * 128 + m * 16) * DFF + col0;
#pragma unroll
                for (int bj = 0; bj < 2; ++bj) { pg8::f32x4 v0 = acc[ai][bj][m][0], v1 = acc[ai][bj][m][1];
#pragma unroll
                    for (int e = 0; e < 4; ++e) { const float a = fmaxf(v0[e], 0.f), c = fmaxf(v1[e], 0.f); v0[e] = a * a; v1[e] = c * c; }
                    u32x4 w; w.x = pk_bf16(v0[0], v0[1]); w.y = pk_bf16(v0[2], v0[3]); w.z = pk_bf16(v1[0], v1[1]); w.w = pk_bf16(v1[2], v1[3]);
                    *(u32x4*)(rowp + bj * 128) = w; } }
    }
};
struct EpiResid {
    static constexpr bool PERM = false, AFTER_DRAIN = false;
    const float* base; float* out;
    __device__ __forceinline__ void operator()(const pg8::f32x4 (&acc)[2][2][4][2], const pg8::Unit& u, int wr, int wc, int fr, int fq) const {
        const int row0 = u.pm * 256 + wr * 64 + fr, col0 = u.pn * 256 + wc * 32 + 4 * fq;
#pragma unroll
        for (int ai = 0; ai < 2; ++ai)
#pragma unroll
            for (int m = 0; m < 4; ++m) { const size_t off = (size_t)(row0 + ai * 128 + m * 16) * DM + col0;
#pragma unroll
                for (int bj = 0; bj < 2; ++bj)
#pragma unroll
                    for (int n = 0; n < 2; ++n) { const pg8::f32x4 bs = *(const pg8::f32x4*)(base + off + bj * 128 + n * 16);
                        *(pg8::f32x4*)(out + off + bj * 128 + n * 16) = bs * ALPHA + acc[ai][bj][m][n]; } }
    }
};

#define XB_TMO      128
#define XB_XCNT(j)  (256  + 64 * (j))
#define XB_XSUB(j)  (1280 + 64 * (j))
#define XB_XGEN(j)  (2304 + 64 * (j))
#define XB_TOP      3328
#define XB_TOPGEN   3392
#define XCD_BAR_WORDS 3456
#define XB_SPIN_CAP (1u << 18)

__device__ __forceinline__ unsigned xb_ld(unsigned* p)              { return __hip_atomic_load(p, __ATOMIC_RELAXED, __HIP_MEMORY_SCOPE_AGENT); }
__device__ __forceinline__ unsigned xb_add(unsigned* p, unsigned v) { return __hip_atomic_fetch_add(p, v, __ATOMIC_RELAXED, __HIP_MEMORY_SCOPE_AGENT); }
__device__ __forceinline__ unsigned xb_xcc_id() { return (unsigned)__builtin_amdgcn_s_getreg((3 << 11) | 20) & 0xFu; }
#define XB_SPIN(cond, bar) do { unsigned _sp = 0; while (cond) { __builtin_amdgcn_s_sleep(1); \
    if ((++_sp & 255u) == 0u) { if (xb_ld(&(bar)[XB_TMO])) break; if (_sp > XB_SPIN_CAP) { atomicAdd(&(bar)[XB_TMO], 1u); break; } } } } while (0)

struct XcdBarrier {
    unsigned* bar; unsigned x;
    volatile LAS unsigned* st;
};

__device__ __forceinline__ XcdBarrier xcd_barrier_post(unsigned* bar, volatile LAS unsigned* st) {
    XcdBarrier b; b.bar = bar; b.x = xb_xcc_id(); b.st = st;
    if (threadIdx.x == 0) (void)xb_add(&bar[XB_XCNT(b.x)], 1u);
    return b;
}
__device__ __forceinline__ void xcd_barrier_complete(unsigned* bar, unsigned x, unsigned& nloc, unsigned& nx) {
    const unsigned G = gridDim.x * gridDim.y * gridDim.z;
    unsigned sum, cnt, mine, sp = 0u;
    for (;;) {
        sum = 0u; cnt = 0u; mine = 0u;
#pragma unroll
        for (unsigned j = 0; j < 16; ++j) { const unsigned c = xb_ld(&bar[XB_XCNT(j)]); sum += c; cnt += (c > 0u) ? 1u : 0u; mine = (j == x) ? c : mine; }
        if (sum == G) break;
        __builtin_amdgcn_s_sleep(1);
        if ((++sp & 255u) == 0u) { if (xb_ld(&bar[XB_TMO])) break; if (sp > XB_SPIN_CAP) { atomicAdd(&bar[XB_TMO], 1u); break; } }
    }
    nloc = mine > 0u ? mine : 1u; nx = cnt > 0u ? cnt : 1u;
}

__device__ __forceinline__ void xcd_barrier(const XcdBarrier& b) {
    asm volatile("s_waitcnt vmcnt(0)" ::: "memory");
    __syncthreads();
    if (threadIdx.x == 0) {
        unsigned* bar = b.bar;
        __builtin_amdgcn_s_waitcnt(0);
        unsigned nloc = b.st[0], nx = b.st[1];
        if (nloc == 0u) { xcd_barrier_complete(bar, b.x, nloc, nx); b.st[0] = nloc; b.st[1] = nx; }
        const unsigned old = xb_add(&bar[XB_XSUB(b.x)], 1u);
        const unsigned gen = old / nloc;
        if (old + 1u == (gen + 1u) * nloc) {
            __builtin_amdgcn_fence(__ATOMIC_RELEASE, "agent");
            asm volatile("s_waitcnt vmcnt(0)" ::: "memory");
            const unsigned og = xb_add(&bar[XB_TOP], 1u);
            const unsigned tg = og / nx;
            if (og + 1u == (tg + 1u) * nx) xb_add(&bar[XB_TOPGEN], 1u);
            else XB_SPIN(xb_ld(&bar[XB_TOPGEN]) == tg, bar);
            __builtin_amdgcn_fence(__ATOMIC_ACQUIRE, "agent");
            xb_add(&bar[XB_XGEN(b.x)], 1u);
            asm volatile("s_waitcnt vmcnt(0)" ::: "memory");
        } else {
            XB_SPIN(xb_ld(&bar[XB_XGEN(b.x)]) == gen, bar);
            __builtin_amdgcn_fence(__ATOMIC_ACQUIRE, "agent");
            asm volatile("s_waitcnt vmcnt(0)" ::: "memory");
        }
    }
    __syncthreads();
}

__global__ void __launch_bounds__(NTHREADS, 2) mega(Params P) {
    extern __shared__ __attribute__((aligned(16))) unsigned char lds_raw[];
    LAS unsigned char* lds = (LAS unsigned char*)lds_raw;
    cg::grid_group grid = cg::this_grid();
    unsigned char* ws = P.ws;
    const int lo = P.ph_lo, hi = P.ph_hi;
    volatile LAS unsigned* xst = (volatile LAS unsigned*)(lds + LDS_BYTES - 16);
    if (threadIdx.x == 0) { xst[0] = 0u; xst[1] = 0u; }
    __syncthreads();
    const XcdBarrier xbar = xcd_barrier_post((unsigned*)(ws + WS_CTL), xst);
#define IN(k) (lo <= (k) && (k) < hi)
#define SEAM(k) do { if (IN(k) && IN((k) + 1)) xcd_barrier(xbar); } while (0)
    if (P.ph_hi == 99) grid.sync();
    if (IN(0)) phase0(P, lds);
    SEAM(0);
    if (IN(1)) { pg8::Gemm g{(const pg8::bf16_t*)P.out, (const pg8::bf16_t*)(ws + WS_WIN), MTOK, NPROJ, DM}; pg8::StaticOrder S; S.init(MTOK, NPROJ, (int)gridDim.x, (int)blockIdx.x);
        EpiProj E{(bf16_t*)(ws + WS_UZ), (bf16_t*)(ws + WS_XBC)}; pg8::gemm_phase<EpiProj, pg8::StaticOrder>(lds, g, S, E, nullptr); }
    SEAM(1);
    if (IN(2)) phase_conv(P, lds);
    SEAM(2);
    if (IN(3)) phase_mix(P, lds);
    SEAM(3);
    if (IN(4)) phase_rms(P);
    SEAM(4);
    if (IN(5)) { pg8::Gemm g{(const pg8::bf16_t*)(ws + WS_XBC), (const pg8::bf16_t*)(ws + WS_WOUT), MTOK, DM, DMIX}; pg8::StaticOrder S; S.init(MTOK, DM, (int)gridDim.x, (int)blockIdx.x);
        EpiResid E{P.in[0], P.out}; pg8::gemm_phase<EpiResid, pg8::StaticOrder>(lds, g, S, E, nullptr); }
    SEAM(5);
    if (IN(6)) phase_ln(P.in[11], P.in[12], P.out, (bf16_t*)(ws + WS_HB));
    SEAM(6);
    if (IN(7)) { pg8::Gemm g{(const pg8::bf16_t*)(ws + WS_HB), (const pg8::bf16_t*)(ws + WS_WFF1), MTOK, DFF, DM}; pg8::StaticOrder S; S.init(MTOK, DFF, (int)gridDim.x, (int)blockIdx.x);
        EpiRelu2 E{(bf16_t*)(ws + WS_H1)}; pg8::gemm_phase<EpiRelu2, pg8::StaticOrder>(lds, g, S, E, nullptr); }
    SEAM(7);
    if (IN(8)) { pg8::Gemm g{(const pg8::bf16_t*)(ws + WS_H1), (const pg8::bf16_t*)(ws + WS_WFF2), MTOK, DM, DFF}; pg8::StaticOrder S; S.init(MTOK, DM, (int)gridDim.x, (int)blockIdx.x);
        EpiResid E{P.out, P.out}; pg8::gemm_phase<EpiResid, pg8::StaticOrder>(lds, g, S, E, nullptr); }
    SEAM(8);
    if (IN(9)) phase_ln(P.in[15], P.in[16], P.out, nullptr);
#undef IN
#undef SEAM
}
}

#ifndef MK_N_LAUNCHES
#define MK_N_LAUNCHES 1
#endif
extern "C" void kernel_launch(void* const* d_in, const int* in_sizes, int n_in, void* d_out, int out_size, void* d_ws, size_t ws_size, hipStream_t stream) {
    static int grid = 0;
    if (grid == 0) {
        if (n_in != 17 || out_size != mk::MTOK * mk::DM || ws_size < mk::WS_END) { fprintf(stderr, "kernel_launch: unexpected shapes (n_in %d out %d ws %zu)\n", n_in, out_size, ws_size); grid = -1; return; }
        int dev = 0, cus = 0, per_cu = 0;
        hipGetDevice(&dev); hipDeviceGetAttribute(&cus, hipDeviceAttributeMultiprocessorCount, dev);
        if (hipFuncSetAttribute((const void*)mk::mega, hipFuncAttributeMaxDynamicSharedMemorySize, mk::LDS_BYTES) != hipSuccess) { fprintf(stderr, "kernel_launch: hipFuncSetAttribute failed\n"); }
        if (hipOccupancyMaxActiveBlocksPerMultiprocessor(&per_cu, (const void*)mk::mega, mk::NTHREADS, mk::LDS_BYTES) != hipSuccess || per_cu < 1) { fprintf(stderr, "kernel_launch: occupancy query says %d\n", per_cu); per_cu = 1; }
        (void)hipGetLastError();
        grid = cus * per_cu;
        fprintf(stderr, "kernel_launch: grid %d (%d CUs x %d)\n", grid, cus, per_cu);
    }
    if (grid < 0) return;
    mk::Params p{};
    for (int i = 0; i < 17; ++i) p.in[i] = (const float*)d_in[i];
    p.out = (float*)d_out; p.ws = (unsigned char*)d_ws;
#if MK_N_LAUNCHES == 1
    p.ph_lo = 0; p.ph_hi = 10;
    if (hipMemsetAsync((unsigned char*)d_ws + mk::WS_CTL, 0, 16384, stream) != hipSuccess) { fprintf(stderr, "kernel_launch: memset of the barrier word failed\n"); return; }
    void* args[] = {&p};
    hipError_t e = hipLaunchCooperativeKernel((const void*)mk::mega, dim3(grid), dim3(mk::NTHREADS), args, mk::LDS_BYTES, stream);
    if (e != hipSuccess) fprintf(stderr, "kernel_launch: cooperative launch failed: %s (grid %d)\n", hipGetErrorString(e), grid);
#else
    for (int ph = 0; ph < 10; ++ph) { p.ph_lo = ph; p.ph_hi = ph + 1; hipLaunchKernelGGL(mk::mega, dim3(grid), dim3(mk::NTHREADS), mk::LDS_BYTES, stream, p); }
#endif
}
```
